# Optimizing an MI355X kernel written in HIP

```python
import jax, jax.numpy as jnp
from jax import lax
import numpy as np

D_MODEL = 1024
BATCH = 4
SEQ = 8192
DEPTH = 1

FOX_HEADS = 8
FOX_HEAD_DIM = D_MODEL // 16
GLA_HEADS = 4
GLA_HEAD_K = D_MODEL // 16
GLA_HEAD_V = D_MODEL // 8
GLA_GATE_RANK = 16
GLA_GATE_TAU = 16.0
GLA_CHUNK = 64
Q_BLOCK = 128
FOX_W = FOX_HEADS * FOX_HEAD_DIM
GLA_KW = GLA_HEADS * GLA_HEAD_K
GLA_VW = GLA_HEADS * GLA_HEAD_V
D_MIX = FOX_W + GLA_VW
IN_SPLITS = (FOX_W, FOX_W, FOX_W, FOX_HEADS, GLA_KW, GLA_KW, GLA_VW, GLA_VW, GLA_GATE_RANK)
D_IN = FOX_W * 3 + FOX_HEADS + GLA_KW * 2 + GLA_VW * 2 + GLA_GATE_RANK
N_MEM = 256
MEM_HEADS = 4
MEM_HEAD_DIM = D_MODEL // MEM_HEADS
D_FF = 2816
MACARON_W = 0.5
RMS_EPS = 1e-6

kernel_name = "fox_gla_hymba_macaron_sandwich_layer"


def rmsnorm(x, g):
    xf = x.astype(jnp.float32)
    y = xf * lax.rsqrt(jnp.mean(xf * xf, axis=-1, keepdims=True) + RMS_EPS)
    return (y * g.astype(jnp.float32)).astype(x.dtype)


def swiglu(x, w_gu, w_down):
    gate, up = jnp.split(x @ w_gu, 2, axis=-1)
    return (jax.nn.silu(gate) * up) @ w_down


def fox_attention(q, k, v, log_f):
    B, S, H, Dh = q.shape
    nb = S // Q_BLOCK
    c = jnp.cumsum(log_f, axis=1).transpose(0, 2, 1)
    kt = k.transpose(0, 2, 1, 3)
    vt = v.transpose(0, 2, 1, 3)
    qb = q.reshape(B, nb, Q_BLOCK, H, Dh).transpose(1, 0, 3, 2, 4)
    cb = c.reshape(B, H, nb, Q_BLOCK).transpose(2, 0, 1, 3)
    k_pos = jnp.arange(S)
    scale = Dh ** -0.5

    def block(args):
        qi, ci, i = args
        s = jnp.einsum('bhqd,bhkd->bhqk', qi, kt).astype(jnp.float32) * scale
        s = s + ci[..., None] - c[:, :, None, :]
        q_pos = i * Q_BLOCK + jnp.arange(Q_BLOCK)
        s = jnp.where(k_pos[None, :] <= q_pos[:, None], s, -jnp.inf)
        p = jax.nn.softmax(s, axis=-1).astype(vt.dtype)
        return jnp.einsum('bhqk,bhkd->bhqd', p, vt)

    o = lax.map(block, (qb, cb, jnp.arange(nb)))
    return o.transpose(1, 0, 3, 2, 4).reshape(B, S, H * Dh)


def gla_chunked(q, k, v, log_a):
    B, S, H, Dk = q.shape
    Dv = v.shape[-1]
    C = GLA_CHUNK
    nc = S // C
    f32 = jnp.float32
    qc = q.astype(f32).reshape(B, nc, C, H, Dk) * (Dk ** -0.5)
    kc = k.astype(f32).reshape(B, nc, C, H, Dk)
    vc = v.astype(f32).reshape(B, nc, C, H, Dv)
    b = jnp.cumsum(log_a.reshape(B, nc, C, H, Dk), axis=2)
    b_last = b[:, :, -1]
    q_dec = qc * jnp.exp(b)
    k_dec = kc * jnp.exp(-b)
    k_to_end = kc * jnp.exp(b_last[:, :, None] - b)
    causal = jnp.tril(jnp.ones((C, C), dtype=bool))
    a = jnp.einsum('bnihd,bnjhd->bnhij', q_dec, k_dec)
    a = jnp.where(causal, a, 0.0)
    o_intra = jnp.einsum('bnhij,bnjhv->bnihv', a, vc)
    s_chunk = jnp.einsum('bnchd,bnchv->nbhdv', k_to_end, vc)
    decay = jnp.exp(b_last).transpose(1, 0, 2, 3)

    def step(state, inp):
        d, sc = inp
        return d[..., None] * state + sc, state

    _, s_prev = lax.scan(step, jnp.zeros((B, H, Dk, Dv), f32), (decay, s_chunk))
    o_inter = jnp.einsum('bnihd,nbhdv->bnihv', q_dec, s_prev)
    return (o_intra + o_inter).reshape(B, S, H, Dv)


def hybrid_mixer(u, w_in, w_a2, b_a, b_f, g_gla, w_out):
    B, S, _ = u.shape
    offsets = [int(o) for o in np.cumsum(IN_SPLITS)[:-1]]
    fq, fk, fv, fz, gq, gk, gv, gr, ga = jnp.split(u @ w_in, offsets, axis=-1)
    log_f = jax.nn.log_sigmoid((fz + b_f).astype(jnp.float32))
    shp = (B, S, FOX_HEADS, FOX_HEAD_DIM)
    o_fox = fox_attention(fq.reshape(shp), fk.reshape(shp), fv.reshape(shp), log_f)
    log_a = jax.nn.log_sigmoid((ga @ w_a2 + b_a).astype(jnp.float32)) / GLA_GATE_TAU
    o_gla = gla_chunked(gq.reshape(B, S, GLA_HEADS, GLA_HEAD_K),
                        gk.reshape(B, S, GLA_HEADS, GLA_HEAD_K),
                        gv.reshape(B, S, GLA_HEADS, GLA_HEAD_V),
                        log_a.reshape(B, S, GLA_HEADS, GLA_HEAD_K)).astype(u.dtype)
    o_gla = rmsnorm(o_gla, g_gla.reshape(GLA_HEADS, GLA_HEAD_V)).reshape(B, S, GLA_VW)
    o_gla = o_gla * jax.nn.silu(gr)
    return jnp.concatenate([o_fox, o_gla], axis=-1) @ w_out


def memory_cross_attention(u, mem_n, w_mq, w_mkv, w_mo):
    B, S, _ = u.shape
    q = (u @ w_mq).reshape(B, S, MEM_HEADS, MEM_HEAD_DIM)
    k, v = jnp.split(mem_n @ w_mkv, 2, axis=-1)
    k = k.reshape(B, N_MEM, MEM_HEADS, MEM_HEAD_DIM)
    v = v.reshape(B, N_MEM, MEM_HEADS, MEM_HEAD_DIM)
    s = jnp.einsum('bshd,bnhd->bhsn', q, k).astype(jnp.float32) * (MEM_HEAD_DIM ** -0.5)
    p = jax.nn.softmax(s, axis=-1).astype(v.dtype)
    o = jnp.einsum('bhsn,bnhd->bshd', p, v).reshape(B, S, D_MODEL)
    return o @ w_mo


def _normal(k, shape, scale):
    return scale * jax.random.normal(k, shape, jnp.float32)


def _gain(k, shape):
    return 1.0 + 0.02 * jax.random.normal(k, shape, jnp.float32)


def setup_inputs(seed: int = 0) -> dict:
    key = jax.random.key(seed)
    ks = jax.random.split(key, 24)
    L = DEPTH
    return {
        "x": jax.random.normal(ks[0], (BATCH, SEQ, D_MODEL), jnp.float32),
        "mem": jax.random.normal(ks[1], (BATCH, N_MEM, D_MODEL), jnp.float32),
        "ffn1_g_pre": _gain(ks[2], (L, D_MODEL)),
        "ffn1_w_gu": _normal(ks[3], (L, D_MODEL, 2 * D_FF), D_MODEL ** -0.5),
        "ffn1_w_down": _normal(ks[4], (L, D_FF, D_MODEL), D_FF ** -0.5),
        "ffn1_g_post": _gain(ks[5], (L, D_MODEL)),
        "mix_g_pre": _gain(ks[6], (L, D_MODEL)),
        "mix_w_in": _normal(ks[7], (L, D_MODEL, D_IN), D_MODEL ** -0.5),
        "mix_w_a2": _normal(ks[8], (L, GLA_GATE_RANK, GLA_KW), GLA_GATE_RANK ** -0.5),
        "mix_b_a": _normal(ks[9], (L, GLA_KW), 0.1),
        "mix_b_f": _normal(ks[10], (L, FOX_HEADS), 0.1),
        "mix_g_gla": _gain(ks[11], (L, GLA_VW)),
        "mix_w_out": _normal(ks[12], (L, D_MIX, D_MODEL), D_MIX ** -0.5),
        "mix_g_post": _gain(ks[13], (L, D_MODEL)),
        "mem_g_pre": _gain(ks[14], (L, D_MODEL)),
        "mem_g_kv": _gain(ks[15], (L, D_MODEL)),
        "mem_w_q": _normal(ks[16], (L, D_MODEL, D_MODEL), D_MODEL ** -0.5),
        "mem_w_kv": _normal(ks[17], (L, D_MODEL, 2 * D_MODEL), D_MODEL ** -0.5),
        "mem_w_o": _normal(ks[18], (L, D_MODEL, D_MODEL), D_MODEL ** -0.5),
        "mem_g_post": _gain(ks[19], (L, D_MODEL)),
        "ffn2_g_pre": _gain(ks[20], (L, D_MODEL)),
        "ffn2_w_gu": _normal(ks[21], (L, D_MODEL, 2 * D_FF), D_MODEL ** -0.5),
        "ffn2_w_down": _normal(ks[22], (L, D_FF, D_MODEL), D_FF ** -0.5),
        "ffn2_g_post": _gain(ks[23], (L, D_MODEL)),
    }


def reference(x, mem, ffn1_g_pre, ffn1_w_gu, ffn1_w_down, ffn1_g_post,
              mix_g_pre, mix_w_in, mix_w_a2, mix_b_a, mix_b_f, mix_g_gla, mix_w_out, mix_g_post,
              mem_g_pre, mem_g_kv, mem_w_q, mem_w_kv, mem_w_o, mem_g_post,
              ffn2_g_pre, ffn2_w_gu, ffn2_w_down, ffn2_g_post):
    h = x
    for l in range(DEPTH):
        f = swiglu(rmsnorm(h, ffn1_g_pre[l]), ffn1_w_gu[l], ffn1_w_down[l])
        h = h + MACARON_W * rmsnorm(f, ffn1_g_post[l])
        m = hybrid_mixer(rmsnorm(h, mix_g_pre[l]), mix_w_in[l], mix_w_a2[l], mix_b_a[l],
                         mix_b_f[l], mix_g_gla[l], mix_w_out[l])
        h = h + rmsnorm(m, mix_g_post[l])
        c = memory_cross_attention(rmsnorm(h, mem_g_pre[l]), rmsnorm(mem, mem_g_kv[l]),
                                   mem_w_q[l], mem_w_kv[l], mem_w_o[l])
        h = h + rmsnorm(c, mem_g_post[l])
        f = swiglu(rmsnorm(h, ffn2_g_pre[l]), ffn2_w_gu[l], ffn2_w_down[l])
        h = h + MACARON_W * rmsnorm(f, ffn2_g_post[l])
    return h
```

```cpp
#include <hip/hip_runtime.h>
#include <hip/hip_cooperative_groups.h>
#include <cstdio>
#include <cstdint>
namespace pg8 {
#define PG8_LAS __attribute__((address_space(3)))
typedef unsigned short bf16_t;
typedef short bf16x8 __attribute__((ext_vector_type(8)));
typedef float f32x4 __attribute__((ext_vector_type(4)));
typedef unsigned u32x4 __attribute__((ext_vector_type(4)));
constexpr int BM = 256, BK = 64, HALF = 128, HTB = HALF * BK * 2  , STAGE_BYTES = 8 * HTB, NXCD = 8, WGM = 2;

__host__ __device__ __forceinline__ int lds_byte(int r, int c) { const int st = (r >> 4) * 2 + (c >> 5), rr = r & 15, cc = c & 31, ob = rr * 64 + cc * 2; return st * 1024 + (ob ^ (((ob >> 9) & 1) << 5)); }
__host__ __device__ __forceinline__ void stage_rc(int b, int& R, int& C) { const int st = b / 1024, sb = b % 1024, swz = sb ^ (((sb >> 9) & 1) << 5); R = (st >> 1) * 16 + swz / 64; C = (st & 1) * 32 + (swz % 64) / 2; }
__host__ __device__ __forceinline__ int perm32(int rho) { const int n = rho >> 4, i = rho & 15; return 8 * (i >> 2) + 4 * n + (i & 3); }

struct Unit { int pm, pn; };
struct Gemm { const bf16_t* A; const bf16_t* Bt; int M, N, K; };

struct StaticOrder {
    int nM, nN, nwg, G, c;
    __host__ __device__ void init(int M, int N, int G_, int c_) { nM = M / BM; nN = N / BM; nwg = nM * nN; G = G_; c = c_; }
    __host__ __device__ bool next(int i, Unit& u) const {
        const long L = (long)i * G + c; if (L >= nwg) return false;
        int wgid = (int)L; { const int q = nwg / NXCD, r = nwg % NXCD, xcd = wgid % NXCD, off = wgid / NXCD; wgid = (xcd < r ? xcd * (q + 1) : r * (q + 1) + (xcd - r) * q) + off; }
        const int nig = WGM * nN, gid = wgid / nig, fm = gid * WGM, gsz = (nM - fm) < WGM ? (nM - fm) : WGM;
        u.pm = fm + ((wgid % nig) % gsz); u.pn = (wgid % nig) / gsz; return true;
    }
    __device__ __forceinline__ void a_ready(const Unit&) const {}
    __device__ __forceinline__ void done(const Unit&) const {}
};

__device__ __forceinline__ unsigned cvt_pk_bf16(float lo, float hi) { unsigned r; asm volatile("v_cvt_pk_bf16_f32 %0, %1, %2" : "=v"(r) : "v"(lo), "v"(hi)); return r; }
typedef float f32x2 __attribute__((ext_vector_type(2)));
__device__ __forceinline__ f32x2 gelu_pk(f32x2 v) {
    const f32x2 av = __builtin_elementwise_abs(v), d = av * 0.2316418882f + 1.0f;
    f32x2 t; t.x = __builtin_amdgcn_rcpf(d.x); t.y = __builtin_amdgcn_rcpf(d.y);
    f32x2 q = t * 0.5307027145f + (-0.7265760135f); q = q * t + 0.7107068705f; q = q * t + (-0.142248368f); q = q * t + 0.127414796f; q = q * t;
    const f32x2 s = (v * v) * (-0.72134752044f);
    f32x2 e; e.x = __builtin_amdgcn_exp2f(s.x); e.y = __builtin_amdgcn_exp2f(s.y);
    const f32x2 m = v * (q * e), r = v - m;
    f32x2 o; o.x = v.x < 0.f ? m.x : r.x; o.y = v.y < 0.f ? m.y : r.y; return o;
}

template <int ACT  > struct EpiBf16 {
    static constexpr bool PERM = true, AFTER_DRAIN = false; static_assert(ACT == 0 || ACT == 1, "EpiBf16: ACT is 0 (none) or 1 (gelu_pk)");
    bf16_t* O; int ldc; const float* bias; int split_cols; size_t split_stride; float scale0;
    __device__ __forceinline__ void operator()(const f32x4 (&acc)[2][2][4][2], const Unit& u, int wr, int wc, int fr, int fq) const {
        const int row0 = u.pm * BM + wr * 64 + fr; int colt = u.pn * BM; bf16_t* base = O;
        float sc = 1.f; if (split_cols) { const int t = colt / split_cols; base += (size_t)t * split_stride; colt -= t * split_cols; if (t == 0) sc = scale0; }
        const int col0 = colt + wc * 32 + 8 * fq, bcol0 = u.pn * BM + wc * 32 + 8 * fq;
        f32x4 bv[2][2];
#pragma unroll
        for (int bj = 0; bj < 2; ++bj)
#pragma unroll
            for (int n = 0; n < 2; ++n) bv[bj][n] = bias ? *(const f32x4*)(bias + bcol0 + bj * HALF + 4 * n) : (f32x4){0.f, 0.f, 0.f, 0.f};
#pragma unroll
        for (int ai = 0; ai < 2; ++ai)
#pragma unroll
            for (int m = 0; m < 4; ++m) { bf16_t* rowp = base + (size_t)(row0 + ai * HALF + m * 16) * ldc + col0;
#pragma unroll
                for (int bj = 0; bj < 2; ++bj) { f32x4 v0 = acc[ai][bj][m][0] + bv[bj][0], v1 = acc[ai][bj][m][1] + bv[bj][1];
                    if (ACT == 1) { f32x2 a = gelu_pk((f32x2){v0[0], v0[1]}), b = gelu_pk((f32x2){v0[2], v0[3]}), c = gelu_pk((f32x2){v1[0], v1[1]}), d = gelu_pk((f32x2){v1[2], v1[3]});
                        v0 = (f32x4){a.x, a.y, b.x, b.y}; v1 = (f32x4){c.x, c.y, d.x, d.y}; }
                    v0 = v0 * sc; v1 = v1 * sc; u32x4 w; w.x = cvt_pk_bf16(v0[0], v0[1]); w.y = cvt_pk_bf16(v0[2], v0[3]); w.z = cvt_pk_bf16(v1[0], v1[1]); w.w = cvt_pk_bf16(v1[2], v1[3]);
                    *(u32x4*)(rowp + bj * HALF) = w; } }
    }
};
template <class Epi, class Sched, bool ALIGN_EPI = false, bool SP2 = false>
__device__ __forceinline__ void gemm_phase(PG8_LAS unsigned char* lds, const Gemm g, const Sched& S, const Epi& E) {
    const int tid = threadIdx.x, wid = __builtin_amdgcn_readfirstlane(tid >> 6), lane = tid & 63, wr = wid >> 2, wc = wid & 3, fr = lane & 15, fq = lane >> 4;
    const int K = g.K, nt = K / BK;
    unsigned voffA[2], voffB[2];
#pragma unroll
    for (int i = 0; i < 2; ++i) { int R, C; stage_rc(tid * 16 + i * 8192, R, C); const int Rb = Epi::PERM ? ((R & ~31) + perm32(R & 31)) : R;
        voffA[i] = (unsigned)(R * K + C) * 2u; voffB[i] = (unsigned)(Rb * K + C) * 2u; }
    const size_t kstep = (size_t)(BK * 2);
    const size_t hstep = (size_t)HALF * K * 2;
    const size_t tstep = 2 * hstep;
    const unsigned ldsw = (unsigned)wid * 1024u;
    const int aoff = lds_byte(wr * 64 + fr, fq * 8), boff = lds_byte(wc * 32 + fr, fq * 8);
#define PG8_SA(b, h) (((b) * 2 + (h)) * HTB)
#define PG8_SB(b, h) ((4 + (b) * 2 + (h)) * HTB)
#define PG8_STAGE(bufoff, gbase, voff) do { _Pragma("unroll") for (int _i = 0; _i < 2; ++_i) \
        __builtin_amdgcn_global_load_lds((const unsigned*)((const char*)(gbase) + (voff)[_i]), (PG8_LAS unsigned*)(lds + (bufoff) + ldsw + _i * 8192), 16, 0, 0); } while (0)
#define PG8_LDA(dst, b, h) do { _Pragma("unroll") for (int m = 0; m < 4; ++m) _Pragma("unroll") for (int k = 0; k < 2; ++k) dst[m][k] = *(const PG8_LAS bf16x8*)(lds + PG8_SA(b, h) + aoff + m * 2048 + k * 1024); } while (0)
#define PG8_LDB(dst, b, h) do { _Pragma("unroll") for (int n = 0; n < 2; ++n) _Pragma("unroll") for (int k = 0; k < 2; ++k) dst[n][k] = *(const PG8_LAS bf16x8*)(lds + PG8_SB(b, h) + boff + n * 2048 + k * 1024); } while (0)
#define PG8_MMA(ai, bj, At, Bt) do { __builtin_amdgcn_s_setprio(1); _Pragma("unroll") for (int m = 0; m < 4; ++m) _Pragma("unroll") for (int n = 0; n < 2; ++n) _Pragma("unroll") for (int k = 0; k < 2; ++k) \
        acc[ai][bj][m][n] = __builtin_amdgcn_mfma_f32_16x16x32_bf16(Bt[n][k], At[m][k], acc[ai][bj][m][n], 0, 0, 0); __builtin_amdgcn_s_setprio(0); } while (0)
#define PG8_WAIT_V(n) asm volatile("s_waitcnt vmcnt(" #n ")" ::: "memory")
#define PG8_WAIT_L(n) asm volatile("s_waitcnt lgkmcnt(" #n ")" ::: "memory")
#define PG8_BAR __builtin_amdgcn_s_barrier()
#define PG8_SCHED __builtin_amdgcn_sched_barrier(0)
    Unit cur, nxt; int ui = 0;
    if (!S.next(0, cur)) return;
    f32x4 acc[2][2][4][2];
#pragma unroll
    for (int a = 0; a < 2; ++a)
#pragma unroll
        for (int b = 0; b < 2; ++b)
#pragma unroll
            for (int m = 0; m < 4; ++m)
#pragma unroll
                for (int n = 0; n < 2; ++n) acc[a][b][m][n] = (f32x4){0.f, 0.f, 0.f, 0.f};
    bf16x8 At[4][2], B0[2][2], B1[2][2];
    const char* cA = (const char*)g.A + (size_t)cur.pm * tstep; const char* cB = (const char*)g.Bt + (size_t)cur.pn * tstep;
    S.a_ready(cur);
    if constexpr (SP2) {
        PG8_STAGE(PG8_SB(0, 0), cB, voffB); PG8_STAGE(PG8_SB(0, 1), cB + hstep, voffB); PG8_STAGE(PG8_SA(0, 0), cA, voffA); PG8_STAGE(PG8_SA(0, 1), cA + hstep, voffA);
        if (wr == 1) PG8_BAR;
        PG8_WAIT_V(2); PG8_BAR;
        PG8_STAGE(PG8_SB(1, 0), cB + kstep, voffB); PG8_STAGE(PG8_SA(1, 0), cA + kstep, voffA); PG8_STAGE(PG8_SB(1, 1), cB + hstep + kstep, voffB);
        PG8_WAIT_V(6); PG8_BAR;
    } else {
        PG8_STAGE(PG8_SB(0, 0), cB, voffB); PG8_STAGE(PG8_SA(0, 0), cA, voffA); PG8_STAGE(PG8_SB(0, 1), cB + hstep, voffB); PG8_STAGE(PG8_SA(0, 1), cA + hstep, voffA);
        if (wr == 1) PG8_BAR;
        PG8_WAIT_V(4); PG8_BAR;
        PG8_STAGE(PG8_SB(1, 0), cB + kstep, voffB); PG8_STAGE(PG8_SA(1, 0), cA + kstep, voffA); PG8_STAGE(PG8_SB(1, 1), cB + hstep + kstep, voffB);
        PG8_WAIT_V(6); PG8_BAR;
    }
    for (;;) {
        const bool has_next = S.next(ui + 1, nxt);
        const char* nA = has_next ? (const char*)g.A + (size_t)nxt.pm * tstep : cA; const char* nB = has_next ? (const char*)g.Bt + (size_t)nxt.pn * tstep : cB;
        for (int t = 0; t < nt; t += 2) {
            const bool last = (t == nt - 2);
            const char* a1 = cA + (size_t)(t + 1) * kstep;
            const char* a2 = last ? nA : cA + (size_t)(t + 2) * kstep; const char* b2 = last ? nB : cB + (size_t)(t + 2) * kstep;
            const char* a3 = a2 + kstep; const char* b3 = b2 + kstep;
            if (last && has_next) S.a_ready(nxt);
            if constexpr (SP2) {
            PG8_LDB(B0, 0, 0); PG8_LDB(B1, 0, 1); PG8_SCHED; PG8_LDA(At, 0, 0); PG8_STAGE(PG8_SA(1, 1), a1 + hstep, voffA);
            PG8_WAIT_V(8); PG8_WAIT_L(0); PG8_BAR; PG8_MMA(0, 0, At, B0); PG8_MMA(0, 1, At, B1); PG8_BAR; PG8_SCHED;
            PG8_LDA(At, 0, 1); PG8_STAGE(PG8_SB(0, 0), b2, voffB); PG8_STAGE(PG8_SB(0, 1), b2 + hstep, voffB); PG8_STAGE(PG8_SA(0, 0), a2, voffA);
            PG8_WAIT_V(8); PG8_WAIT_L(0); PG8_BAR; PG8_MMA(1, 0, At, B0); PG8_MMA(1, 1, At, B1); PG8_BAR; PG8_SCHED;
            PG8_LDB(B0, 1, 0); PG8_LDB(B1, 1, 1); PG8_SCHED; PG8_LDA(At, 1, 0); PG8_STAGE(PG8_SA(0, 1), a2 + hstep, voffA);
            PG8_WAIT_V(8); PG8_WAIT_L(0); PG8_BAR; PG8_MMA(0, 0, At, B0); PG8_MMA(0, 1, At, B1); PG8_BAR; PG8_SCHED;
            PG8_LDA(At, 1, 1); PG8_STAGE(PG8_SB(1, 0), b3, voffB); PG8_STAGE(PG8_SB(1, 1), b3 + hstep, voffB); PG8_STAGE(PG8_SA(1, 0), a3, voffA);
            PG8_WAIT_V(8); PG8_WAIT_L(0); PG8_BAR; PG8_MMA(1, 0, At, B0); PG8_MMA(1, 1, At, B1); PG8_BAR; PG8_SCHED;
            } else {
            PG8_LDB(B0, 0, 0); PG8_SCHED; PG8_LDA(At, 0, 0); PG8_STAGE(PG8_SA(1, 1), a1 + hstep, voffA);
            PG8_WAIT_L(8); PG8_BAR; PG8_WAIT_L(0); PG8_MMA(0, 0, At, B0); PG8_BAR; PG8_SCHED;
            PG8_LDB(B1, 0, 1); PG8_STAGE(PG8_SB(0, 0), b2, voffB);
            PG8_BAR; PG8_WAIT_L(0); PG8_MMA(0, 1, At, B1); PG8_BAR;
            PG8_LDA(At, 0, 1); PG8_STAGE(PG8_SA(0, 0), a2, voffA);
            PG8_BAR; PG8_WAIT_L(0); PG8_MMA(1, 0, At, B0); PG8_BAR; PG8_SCHED;
            PG8_STAGE(PG8_SB(0, 1), b2 + hstep, voffB);
            PG8_WAIT_V(6); PG8_BAR; PG8_MMA(1, 1, At, B1); PG8_BAR;
            PG8_LDB(B0, 1, 0); PG8_SCHED; PG8_LDA(At, 1, 0); PG8_STAGE(PG8_SA(0, 1), a2 + hstep, voffA);
            PG8_WAIT_L(8); PG8_BAR; PG8_WAIT_L(0); PG8_MMA(0, 0, At, B0); PG8_BAR; PG8_SCHED;
            PG8_LDB(B1, 1, 1); PG8_STAGE(PG8_SB(1, 0), b3, voffB);
            PG8_BAR; PG8_WAIT_L(0); PG8_MMA(0, 1, At, B1); PG8_BAR;
            PG8_LDA(At, 1, 1); PG8_STAGE(PG8_SA(1, 0), a3, voffA);
            PG8_BAR; PG8_WAIT_L(0); PG8_MMA(1, 0, At, B0); PG8_BAR; PG8_SCHED;
            PG8_STAGE(PG8_SB(1, 1), b3 + hstep, voffB);
            PG8_WAIT_V(6); PG8_BAR; PG8_MMA(1, 1, At, B1); PG8_BAR;
            }
        }
        if constexpr (ALIGN_EPI) { if (wr == 0) PG8_BAR; }
        if constexpr (!Epi::AFTER_DRAIN) { E(acc, cur, wr, wc, fr, fq); S.done(cur); }
        if (!has_next) break;
#pragma unroll
        for (int a = 0; a < 2; ++a)
#pragma unroll
            for (int b = 0; b < 2; ++b)
#pragma unroll
                for (int m = 0; m < 4; ++m)
#pragma unroll
                    for (int n = 0; n < 2; ++n) acc[a][b][m][n] = (f32x4){0.f, 0.f, 0.f, 0.f};
        cur = nxt; cA = nA; cB = nB; ++ui;
        if constexpr (ALIGN_EPI) { if (wr == 1) PG8_BAR; }
    }
    PG8_WAIT_V(0);
    if constexpr (!ALIGN_EPI) { if (wr == 0) PG8_BAR; }
    PG8_BAR;
    if constexpr (Epi::AFTER_DRAIN) { E.fused(acc, cur, wr, wc, fr, fq, lds, wid, lane); S.done(cur); }
#undef PG8_SA
#undef PG8_SB
#undef PG8_STAGE
#undef PG8_LDA
#undef PG8_LDB
#undef PG8_MMA
#undef PG8_WAIT_V
#undef PG8_WAIT_L
#undef PG8_BAR
#undef PG8_SCHED
}
}
#include <hip/hip_bf16.h>
#include <cmath>
namespace attn_body {
using bf16=__hip_bfloat16;
using bf16x8=__attribute__((ext_vector_type(8)))short;
using s16x4=__attribute__((ext_vector_type(4)))short;
using f32x16=__attribute__((ext_vector_type(16)))float;
using u32x4=__attribute__((ext_vector_type(4)))unsigned;
using f32x4=__attribute__((ext_vector_type(4)))float;
#define ALDS __attribute__((address_space(3)))
constexpr int BATCH=4,NHEAD=8,SEQ=8192,D=64,DM=1024;
constexpr int NW=8,QBLK=32,QB=QBLK*NW,KVBLK=64,NQB=SEQ/QB;
constexpr int ATTN_PITCH=DM, ATTN_UNIT_ROWS=QB;
__device__ __forceinline__ int crow(int r,int hi){return (r&3)+8*(r>>2)+4*hi;}
#define SBAR() __builtin_amdgcn_sched_barrier(0)
__device__ __forceinline__ void cmask(f32x16&p0,f32x16&p1,int jb,int qrel,int hi){
  const float NEG=-INFINITY; const int dq=qrel-64*jb-4*hi;
  #pragma unroll
  for(int r=0;r<16;++r){const int c=(r&3)+8*(r>>2); if(c>dq)p0[r]=NEG; if(c+32>dq)p1[r]=NEG;}
}

constexpr int NSLOT=3, SLOTB=8192;
constexpr int LDS_K=0, LDS_V=NSLOT*SLOTB, LDS_WS=2*NSLOT*SLOTB, LDS_OST=LDS_WS+NW*64*4, LDS_BIAS=LDS_OST+NW*4096, LDS_BYTES=LDS_BIAS+SEQ*4;
constexpr float C2=0.125f*1.4426950408889634f;
__device__ __forceinline__ void glds16(const void*gsrc,unsigned lds_dst){unsigned keep;
  asm volatile("s_mov_b32 %0, m0\n\ts_mov_b32 m0, %2\n\ts_nop 0\n\tglobal_load_lds_dwordx4 %1, off\n\ts_mov_b32 m0, %0":"=&s"(keep):"v"(gsrc),"s"(lds_dst):"memory");}
__device__ __forceinline__ float max3f(float a,float b,float c){float r;asm("v_max3_f32 %0, %1, %2, %3":"=v"(r):"v"(a),"v"(b),"v"(c));return r;}
__device__ __forceinline__ float max2f(float a,float b){float r;asm("v_max_f32_e32 %0, %1, %2":"=v"(r):"v"(a),"v"(b));return r;}
__device__ __forceinline__ float fadd_s(float a,float b){float r;asm("v_add_f32_e32 %0, %1, %2":"=v"(r):"v"(a),"v"(b));return r;}
__device__ __forceinline__ float fsub_s(float a,float b){float r;asm("v_sub_f32_e32 %0, %1, %2":"=v"(r):"v"(a),"v"(b));return r;}
typedef float f32x2_t __attribute__((ext_vector_type(2))); typedef __bf16 bf16x2_t __attribute__((ext_vector_type(2)));
__device__ __forceinline__ unsigned cvtpk_s(float lo,float hi){f32x2_t v={lo,hi};bf16x2_t b=__builtin_convertvector(v,bf16x2_t);return __builtin_bit_cast(unsigned,b);}
#define WAIT_BAR(N) asm volatile("s_waitcnt vmcnt(" #N ") lgkmcnt(0)\n\ts_barrier":::"memory")

__device__ __forceinline__ void qkt(f32x16&p0,f32x16&p1,const char*Kslot,const bf16x8*qr,const f32x16&c0,const f32x16&c1,int r32,int hi){
  const char*kb=Kslot+hi*1024+r32*16;
  #pragma unroll
  for(int d0=0;d0<4;++d0){
    const bf16x8 b0=*reinterpret_cast<const bf16x8*>(kb+d0*2048);
    const bf16x8 b1=*reinterpret_cast<const bf16x8*>(kb+d0*2048+512);
    if(d0==0){p0=__builtin_amdgcn_mfma_f32_32x32x16_bf16(b0,qr[0],c0,0,0,0);p1=__builtin_amdgcn_mfma_f32_32x32x16_bf16(b1,qr[0],c1,0,0,0);}
    else{p0=__builtin_amdgcn_mfma_f32_32x32x16_bf16(b0,qr[d0],p0,0,0,0);p1=__builtin_amdgcn_mfma_f32_32x32x16_bf16(b1,qr[d0],p1,0,0,0);}}
}
typedef __attribute__((address_space(3))) const char* lds_cptr;
typedef short v4i16_t __attribute__((ext_vector_type(4)));
__device__ __forceinline__ void kload8(bf16x8*kf,lds_cptr kp){
  kf[0]=*(const __attribute__((address_space(3))) bf16x8*)(kp);      kf[1]=*(const __attribute__((address_space(3))) bf16x8*)(kp+512);
  kf[2]=*(const __attribute__((address_space(3))) bf16x8*)(kp+2048); kf[3]=*(const __attribute__((address_space(3))) bf16x8*)(kp+2560);
  kf[4]=*(const __attribute__((address_space(3))) bf16x8*)(kp+4096); kf[5]=*(const __attribute__((address_space(3))) bf16x8*)(kp+4608);
  kf[6]=*(const __attribute__((address_space(3))) bf16x8*)(kp+6144); kf[7]=*(const __attribute__((address_space(3))) bf16x8*)(kp+6656);
}
__device__ __forceinline__ void kload2(bf16x8*kf,lds_cptr kp,int j){ kf[2*j]=*(const __attribute__((address_space(3))) bf16x8*)(kp+j*2048); kf[2*j+1]=*(const __attribute__((address_space(3))) bf16x8*)(kp+j*2048+512); }
__device__ __forceinline__ s16x4 vtr(lds_cptr p){ return __builtin_bit_cast(s16x4,__builtin_amdgcn_ds_read_tr16_b64_v4i16((__attribute__((address_space(3))) v4i16_t*)p)); }
__device__ __forceinline__ float rowmax(const f32x16&p0,const f32x16&p1){
  float a=max3f(p0[0],p0[1],p1[0]),b=max3f(p0[2],p0[3],p1[1]);a=max3f(a,p1[2],p1[3]);
  #pragma unroll
  for(int r=4;r<16;r+=4){a=max3f(a,p0[r],p0[r+1]);b=max3f(b,p0[r+2],p0[r+3]);a=max3f(a,p1[r],p1[r+1]);b=max3f(b,p1[r+2],p1[r+3]);}
  const float m=max2f(a,b);
  auto rr=__builtin_amdgcn_permlane32_swap(__float_as_uint(m),__float_as_uint(m),false,false);
  return max2f(__uint_as_float(rr[0]),__uint_as_float(rr[1]));
}
__device__ __forceinline__ void pv(f32x16*o,int vb,bf16x8 pa0,bf16x8 pa1,bf16x8 pa2,bf16x8 pa3){
  #pragma unroll
  for(int d0=0;d0<2;++d0){s16x4 lo[4],hi[4];
    #pragma unroll
    for(int ks=0;ks<4;++ks){
      asm volatile("ds_read_b64_tr_b16 %0,%1 offset:%c2":"=&v"(lo[ks]):"v"(vb),"i"(d0*4096+ks*1024):"memory");
      asm volatile("ds_read_b64_tr_b16 %0,%1 offset:%c2":"=&v"(hi[ks]):"v"(vb),"i"(d0*4096+ks*1024+512):"memory");}
    asm volatile("s_waitcnt lgkmcnt(0)":::"memory");SBAR();
    #define PK(k) (bf16x8){lo[k][0],lo[k][1],lo[k][2],lo[k][3],hi[k][0],hi[k][1],hi[k][2],hi[k][3]}
    o[d0]=__builtin_amdgcn_mfma_f32_32x32x16_bf16(pa0,PK(0),o[d0],0,0,0);
    o[d0]=__builtin_amdgcn_mfma_f32_32x32x16_bf16(pa1,PK(1),o[d0],0,0,0);
    o[d0]=__builtin_amdgcn_mfma_f32_32x32x16_bf16(pa2,PK(2),o[d0],0,0,0);
    o[d0]=__builtin_amdgcn_mfma_f32_32x32x16_bf16(pa3,PK(3),o[d0],0,0,0);
    #undef PK
  }
}

#ifndef ATTN_STORE16
#define ATTN_STORE16(p,v) (*(u32x4*)(p)=(v))
#endif
template<int THRL> __device__ __forceinline__ void attn_unit(int b,int h,int qb,const bf16*Q,const bf16*__restrict__ K,const bf16*__restrict__ V,bf16*O,const float*__restrict__ cfrow,float ub,char*shm){
  const int tid=threadIdx.x,lane=tid&63,r32=lane&31,hi=lane>>5; const int wid=__builtin_amdgcn_readfirstlane(tid>>6);
  const long rowbase=(long)b*SEQ; const int q0=qb*QB;
  const int NT0=(q0+QB)/KVBLK; int t0;
  { const float cref0=cfrow[q0], thr=-(2.f*ub+43.f); const int j0=lane,j1=lane+64;
    const bool p0=(j0<NT0-4)&&((cref0-cfrow[64*j0+63])*1.4426950408889634f<=thr);
    const bool p1=(j1<NT0-4)&&((cref0-cfrow[64*j1+63])*1.4426950408889634f<=thr);
    t0=(__popcll(__ballot(p0))+__popcll(__ballot(p1)))&~1; t0=__builtin_amdgcn_readfirstlane(t0); }
  const bf16*Qw=Q+(rowbase+q0+wid*QBLK)*DM+h*D;
  const bf16*Kh=K+(rowbase+(long)t0*KVBLK)*DM+h*D,*Vh=V+(rowbase+(long)t0*KVBLK)*DM+h*D;
  const unsigned lds0=(unsigned)(uintptr_t)shm;
  float*wsf=(float*)(shm+LDS_WS)+wid*64;
  const bf16*ksrc=Kh+(long)lane*DM+wid*8;
  const bf16*vsrc=Vh+(long)(16*(wid&3)+(lane>>2))*DM+(wid>>2)*32+(lane&3)*8;
  const unsigned kdst=lds0+LDS_K+wid*1024, vdst=lds0+LDS_V+wid*1024;
  #define DMA_K(t,slot) glds16(ksrc+(long)(t)*KVBLK*DM,(unsigned)__builtin_amdgcn_readfirstlane(kdst+(slot)))
  #define DMA_V(t,slot) glds16(vsrc+(long)(t)*KVBLK*DM,(unsigned)__builtin_amdgcn_readfirstlane(vdst+(slot)))
  const int vb0=(int)(lds0+LDS_V)+((lane>>4)&1)*32+(lane&3)*8+(4*hi+((lane&15)>>2))*64;
  const char*Kbase=shm+LDS_K; bf16x8 kf[8];
  const lds_cptr shm3=(lds_cptr)shm; const lds_cptr kp0=shm3+LDS_K+hi*1024+r32*16; const lds_cptr vp0=shm3+LDS_V+((lane>>4)&1)*32+(lane&3)*8+(4*hi+((lane&15)>>2))*64;
  const int NT=NT0-t0;
  const ALDS float*bl=(const ALDS float*)(shm3+LDS_BIAS)+4*hi;
  #define LDBIAS(X0,X1,t) do{ const ALDS float*bp_=bl+(t)*KVBLK; \
    _Pragma("unroll") for(int g_=0;g_<4;++g_){ const f32x4 a_=*(const ALDS f32x4*)(bp_+8*g_); const f32x4 b_=*(const ALDS f32x4*)(bp_+32+8*g_); \
      X0[4*g_]=a_[0];X0[4*g_+1]=a_[1];X0[4*g_+2]=a_[2];X0[4*g_+3]=a_[3]; X1[4*g_]=b_[0];X1[4*g_+1]=b_[1];X1[4*g_+2]=b_[2];X1[4*g_+3]=b_[3]; } }while(0)
  DMA_K(0,0);DMA_V(0,0);DMA_K(1,SLOTB);
  bf16x8 qr[4];
  #pragma unroll
  for(int d0=0;d0<4;++d0)qr[d0]=*reinterpret_cast<const bf16x8*>(&Qw[(long)r32*DM+d0*16+hi*8]);
  float mhat=0.f,l_reg=0.f;f32x16 o[2];o[0]=f32x16{};o[1]=f32x16{};
  const int qrel=wid*QBLK+r32;
  #define CMASK(P0,P1,t) do{int jb_=(t)-(NT-4); if(jb_>=0)cmask(P0,P1,jb_,qrel,hi);}while(0)
  bool resc=false;
  #define START(P0,P1) do{ const float rm=rowmax(P0,P1); resc=false; \
    { const float dl=rm; mhat=fadd_s(mhat,dl); \
      _Pragma("unroll") for(int r=0;r<16;++r){P0[r]=fsub_s(P0[r],dl);P1[r]=fsub_s(P1[r],dl);} \
      } \
    _Pragma("unroll") for(int r=0;r<16;++r)P0[r]=__builtin_amdgcn_exp2f(P0[r]); }while(0)
  #define RESC() do{ if(resc){ asm volatile("s_waitcnt lgkmcnt(0)":::"memory"); \
      _Pragma("unroll") for(int d_=0;d_<2;++d_) _Pragma("unroll") for(int r=0;r<16;++r)o[d_][r]*=wsf[crow(r,hi)]; } }while(0)
  f32x16 pA0,pA1,pB0,pB1;
  int sl_prev=0,sl_cur=0,sl_next=SLOTB;
  #define ROT() do{sl_prev=sl_cur;sl_cur=sl_next;sl_next=(sl_next==(NSLOT-1)*SLOTB)?0:sl_next+SLOTB;}while(0)
  DMA_K(2,2*SLOTB);
  { const float cref=cfrow[q0]; ALDS float*bw=(ALDS float*)(shm3+LDS_BIAS);
    _Pragma("clang loop unroll(disable) vectorize(disable)")
    for(int i=tid;i<NT*KVBLK;i+=NW*64) bw[i]=(cref-cfrow[t0*KVBLK+i])*1.4426950408889634f; }
  WAIT_BAR(3);
  LDBIAS(pB0,pB1,0); qkt(pA0,pA1,Kbase,qr,pB0,pB1,r32,hi);asm volatile("s_nop 15\n\ts_nop 7":"+v"(pA0),"+v"(pA1));CMASK(pA0,pA1,0);
  START(pA0,pA1);
  _Pragma("unroll") for(int r=0;r<16;++r)pA1[r]=__builtin_amdgcn_exp2f(pA1[r]);
  WAIT_BAR(0);
  DMA_K(3,0);DMA_V(1,SLOTB);
  ROT();
  kload8(kf,kp0+sl_cur);
  WAIT_BAR(2);
  s16x4 vlo[8],vhi[8]; u32x4 pw0,pw1,pw2,pw3;
  #define PKW(P,B) cvtpk_s(P[B],P[B+1])
  #define PAF(k) __builtin_bit_cast(bf16x8,pw##k)
  #define VFR(i) (bf16x8){vlo[i][0],vlo[i][1],vlo[i][2],vlo[i][3],vhi[i][0],vhi[i][1],vhi[i][2],vhi[i][3]}
  #define PIN(x) asm volatile("":"+v"(x))
  #define MX3(a,b,c) __builtin_fmaxf(__builtin_fmaxf((a),(b)),(c))
  #define GAPA(MF,A0,A1,A2,A3,W0,W1,PW) do{ MF; sacc+=A0; sacc+=A1; sacc+=A2; sacc+=A3; PIN(sacc); W0; W1; PIN(PW); SBAR(); }while(0)
  #define EX(v) __builtin_amdgcn_exp2f(v)
  #define GAPB(MF,X,B) do{ MF; X[B]=EX(X[B]); X[B+1]=EX(X[B+1]); X[B+2]=EX(X[B+2]); X[B+3]=EX(X[B+3]); PIN(X); SBAR(); }while(0)
  #define VRD(i) do{ vlo[i]=vtr(vp_+(((i)>>2)*4096+((i)&3)*1024)); vhi[i]=vtr(vp_+(((i)>>2)*4096+((i)&3)*1024+512)); }while(0)
  #define KRD(G,j) do{ if(G){ kload2(kf,kp0+sl_next,j); SBAR(); } }while(0)
  #define STEP(C0,C1,P0,P1,t,GK,GV,GL) do{ SBAR(); \
    _Pragma("unroll") for(int r=0;r<16;++r){C0[r]-=mhat;C1[r]-=mhat;} \
    const lds_cptr vp_=vp0+sl_prev; \
    VRD(0); SBAR(); float sacc=(P0[0]+P0[1]); \
    GAPA(C0=__builtin_amdgcn_mfma_f32_32x32x16_bf16(kf[0],qr[0],C0,0,0,0), P0[2],P0[3],P0[4],P0[5],     pw0[0]=PKW(P0,0), pw0[1]=PKW(P0,2), pw0); \
    VRD(4); SBAR(); GAPA(C1=__builtin_amdgcn_mfma_f32_32x32x16_bf16(kf[1],qr[0],C1,0,0,0), P0[6],P0[7],P0[8],P0[9],     pw0[2]=PKW(P0,4), pw0[3]=PKW(P0,6), pw0); \
    VRD(1); SBAR(); GAPA(C0=__builtin_amdgcn_mfma_f32_32x32x16_bf16(kf[2],qr[1],C0,0,0,0),   P0[10],P0[11],P0[12],P0[13], pw1[0]=PKW(P0,8), pw1[1]=PKW(P0,10), pw1); \
    VRD(5); SBAR(); GAPA(C1=__builtin_amdgcn_mfma_f32_32x32x16_bf16(kf[3],qr[1],C1,0,0,0),   P0[14],P0[15],P1[0],P1[1],   pw1[2]=PKW(P0,12),pw1[3]=PKW(P0,14), pw1); \
    VRD(2); SBAR(); GAPA(C0=__builtin_amdgcn_mfma_f32_32x32x16_bf16(kf[4],qr[2],C0,0,0,0),   P1[2],P1[3],P1[4],P1[5],     pw2[0]=PKW(P1,0), pw2[1]=PKW(P1,2), pw2); \
    VRD(6); SBAR(); GAPA(C1=__builtin_amdgcn_mfma_f32_32x32x16_bf16(kf[5],qr[2],C1,0,0,0),   P1[6],P1[7],P1[8],P1[9],     pw2[2]=PKW(P1,4), pw2[3]=PKW(P1,6), pw2); \
    VRD(3); SBAR(); GAPA(C0=__builtin_amdgcn_mfma_f32_32x32x16_bf16(kf[6],qr[3],C0,0,0,0),   P1[10],P1[11],P1[12],P1[13], pw3[0]=PKW(P1,8), pw3[1]=PKW(P1,10), pw3); \
    VRD(7); SBAR(); GAPA(C1=__builtin_amdgcn_mfma_f32_32x32x16_bf16(kf[7],qr[3],C1,0,0,0),   P1[14],P1[15],0.f,0.f,       pw3[2]=PKW(P1,12),pw3[3]=PKW(P1,14), pw3); \
    l_reg+=sacc; \
    if(GK){DMA_K((t)+3,sl_cur);} if(GV){DMA_V((t)+1,sl_next);} \
    CMASK(C0,C1,t); \
    { float a=MX3(C0[0],C0[1],C1[0]),b=MX3(C0[2],C0[3],C1[1]); a=MX3(a,C1[2],C1[3]); \
      _Pragma("unroll") for(int r=4;r<16;r+=4){a=MX3(a,C0[r],C0[r+1]);b=MX3(b,C0[r+2],C0[r+3]);a=MX3(a,C1[r],C1[r+1]);b=MX3(b,C1[r+2],C1[r+3]);} \
      float rm=__builtin_fmaxf(a,b); { auto rr=__builtin_amdgcn_permlane32_swap(__float_as_uint(rm),__float_as_uint(rm),false,false); rm=__builtin_fmaxf(__uint_as_float(rr[0]),__uint_as_float(rr[1])); } \
      resc=false; \
      if(__builtin_expect(__any(rm>(float)THRL),0)){ const float dl=__builtin_fmaxf(rm,0.f); mhat+=dl; \
        _Pragma("unroll") for(int r=0;r<16;++r){C0[r]-=dl;C1[r]-=dl;} \
        const float f=__builtin_amdgcn_exp2f(-dl); l_reg*=f; if(hi==0)wsf[r32]=f; resc=true; } } \
    SBAR(); \
    GAPB(o[0]=__builtin_amdgcn_mfma_f32_32x32x16_bf16(PAF(0),VFR(0),o[0],0,0,0), C0,0); \
    GAPB(o[1]=__builtin_amdgcn_mfma_f32_32x32x16_bf16(PAF(0),VFR(4),o[1],0,0,0), C0,4); \
    KRD(GL,0); GAPB(o[0]=__builtin_amdgcn_mfma_f32_32x32x16_bf16(PAF(1),VFR(1),o[0],0,0,0), C0,8); \
    KRD(GL,1); GAPB(o[1]=__builtin_amdgcn_mfma_f32_32x32x16_bf16(PAF(1),VFR(5),o[1],0,0,0), C0,12); \
    KRD(GL,2); GAPB(o[0]=__builtin_amdgcn_mfma_f32_32x32x16_bf16(PAF(2),VFR(2),o[0],0,0,0), C1,0); \
    KRD(GL,3); GAPB(o[1]=__builtin_amdgcn_mfma_f32_32x32x16_bf16(PAF(2),VFR(6),o[1],0,0,0), C1,4); \
    GAPB(o[0]=__builtin_amdgcn_mfma_f32_32x32x16_bf16(PAF(3),VFR(3),o[0],0,0,0), C1,8); \
    GAPB(o[1]=__builtin_amdgcn_mfma_f32_32x32x16_bf16(PAF(3),VFR(7),o[1],0,0,0), C1,12); \
    if(GL){LDBIAS(P0,P1,(t)+1);} \
    }while(0)
  LDBIAS(pB0,pB1,1);
  int t=1;
  #undef CMASK
  #define CMASK(P0,P1,t) do{}while(0)
  for(;t+5<NT;t+=2){
    STEP(pB0,pB1,pA0,pA1,t,true,true,true);     WAIT_BAR(2); RESC(); ROT();
    STEP(pA0,pA1,pB0,pB1,t+1,true,true,true);   WAIT_BAR(2); RESC(); ROT();
  }
  #undef CMASK
  #define CMASK(P0,P1,t) do{int jb_=(t)-(NT-4); if(jb_>=0)cmask(P0,P1,jb_,qrel,hi);}while(0)
  #define ENDW(tt) do{ if((tt)+3<NT){WAIT_BAR(2);} else if((tt)+2<NT){WAIT_BAR(1);} else {WAIT_BAR(0);} }while(0)
  for(;t+1<NT;t+=2){
    STEP(pB0,pB1,pA0,pA1,t,(t+3<NT),(t+1<NT),(t+1<NT));       ENDW(t);   RESC(); ROT();
    STEP(pA0,pA1,pB0,pB1,t+1,(t+4<NT),(t+2<NT),(t+2<NT));     ENDW(t+1); RESC(); ROT();
  }
  STEP(pB0,pB1,pA0,pA1,NT-1,false,false,false); RESC();
  { float sacc=pB0[0]+pB0[1]; _Pragma("unroll") for(int r=2;r<16;++r)sacc+=pB0[r]; _Pragma("unroll") for(int r=0;r<16;++r)sacc+=pB1[r]; l_reg+=sacc;
    pw0=(u32x4){PKW(pB0,0),PKW(pB0,2),PKW(pB0,4),PKW(pB0,6)};pw1=(u32x4){PKW(pB0,8),PKW(pB0,10),PKW(pB0,12),PKW(pB0,14)};pw2=(u32x4){PKW(pB1,0),PKW(pB1,2),PKW(pB1,4),PKW(pB1,6)};pw3=(u32x4){PKW(pB1,8),PKW(pB1,10),PKW(pB1,12),PKW(pB1,14)};
    SBAR(); pv(o,vb0+sl_cur,PAF(0),PAF(1),PAF(2),PAF(3)); }
  #undef PKW
  #undef PAF
  #undef VFR
  #undef PIN
  #undef MX3
  #undef GAPA
  #undef GAPB
  #undef EX
  #undef VRD
  #undef KRD
  #undef STEP
  #undef ENDW
  {auto rr=__builtin_amdgcn_permlane32_swap(__float_as_uint(l_reg),__float_as_uint(l_reg),false,false);l_reg=__uint_as_float(rr[0])+__uint_as_float(rr[1]);}
  if(hi==0)wsf[32+r32]=l_reg;asm volatile("s_waitcnt lgkmcnt(0)":::"memory");
  float rli[16];
  #pragma unroll
  for(int r=0;r<16;++r)rli[r]=__builtin_amdgcn_rcpf(wsf[32+crow(r,hi)]);
  bf16*Ow=O+(rowbase+q0+wid*QBLK)*DM+h*D;
  { bf16*stg=(bf16*)(shm+LDS_OST)+wid*2048;
    #pragma unroll
    for(int r=0;r<16;++r){const int orow=crow(r,hi);
      #pragma unroll
      for(int d0=0;d0<2;++d0)stg[orow*64+d0*32+r32]=__float2bfloat16(o[d0][r]*rli[r]);}
    asm volatile("s_waitcnt lgkmcnt(0)":::"memory");
    #pragma unroll
    for(int i=0;i<4;++i){const int row=i*8+(lane>>3),ch=lane&7; const u32x4 v=*(const u32x4*)(stg+row*64+ch*8); ATTN_STORE16(Ow+(long)row*DM+ch*8,v);} }
  asm volatile("s_waitcnt lgkmcnt(0)\n\ts_barrier":::"memory");
  #undef LDBIAS
  #undef DMA_K
  #undef DMA_V
  #undef CMASK
  #undef START
  #undef RESC
  #undef ROT
}
constexpr int ATTN_LDS_BYTES=LDS_BYTES;
struct AttnTensors { const bf16* Q; const bf16* K; const bf16* V; bf16* O; const float* CF; const float* UB; };
struct AttnUnit { int bh; int qb; };
struct StaticOrder {
  int vcu;
  __device__ __forceinline__ explicit StaticOrder(int grid,int block):vcu((block%8)*(grid/8)+block/8){}
  __device__ __forceinline__ bool next(int i,AttnUnit&u)const{ if(i>=4)return false; const int s=vcu&7; u.bh=vcu>>3; u.qb=(i==0)?s:(i==1)?15-s:(i==2)?16+s:31-s; return true; }
  __device__ __forceinline__ void a_ready(const AttnUnit&)const{}
  __device__ __forceinline__ void done(const AttnUnit&)const{}
};
template<class Sched,int THRL=8> __device__ __forceinline__ void attn_phase(char*lds,const AttnTensors&T,const Sched&S){
  AttnUnit u;
  for(int i=0;S.next(i,u);++i){ S.a_ready(u); attn_unit<THRL>(u.bh/NHEAD,u.bh%NHEAD,u.qb,T.Q,T.K,T.V,T.O,T.CF+(long)u.bh*SEQ,sqrtf(T.UB[u.bh]*T.UB[32+u.bh])*1.01f,lds); S.done(u); }
}
#undef SBAR
#undef WAIT_BAR
}

namespace pg8 {
__device__ __forceinline__ float silu_f(float x) { return x * __builtin_amdgcn_rcpf(1.0f + __builtin_amdgcn_exp2f(-1.4426950408889634f * x)); }
struct EpiSwiGLU {
    static constexpr bool PERM = true, AFTER_DRAIN = false;
    bf16_t* O; int ldc; const float* rs;
    __device__ __forceinline__ void operator()(const f32x4 (&acc)[2][2][4][2], const Unit& u, int wr, int wc, int fr, int fq) const {
        const int row0 = u.pm * BM + wr * 64 + fr, col0 = u.pn * HALF + wc * 32 + 8 * fq;
#pragma unroll
        for (int ai = 0; ai < 2; ++ai)
#pragma unroll
            for (int m = 0; m < 4; ++m) { const int row = row0 + ai * HALF + m * 16; const float r = rs[row];
                const f32x4 g0 = acc[ai][0][m][0] * r, g1 = acc[ai][0][m][1] * r, u0 = acc[ai][1][m][0] * r, u1 = acc[ai][1][m][1] * r;
                u32x4 w; w.x = cvt_pk_bf16(silu_f(g0[0]) * u0[0], silu_f(g0[1]) * u0[1]); w.y = cvt_pk_bf16(silu_f(g0[2]) * u0[2], silu_f(g0[3]) * u0[3]);
                w.z = cvt_pk_bf16(silu_f(g1[0]) * u1[0], silu_f(g1[1]) * u1[1]); w.w = cvt_pk_bf16(silu_f(g1[2]) * u1[2], silu_f(g1[3]) * u1[3]);
                __builtin_nontemporal_store(w, (u32x4*)(O + (size_t)row * ldc + col0)); }
    }
};
struct EpiRowSS {
    static constexpr bool PERM = true, AFTER_DRAIN = false;
    bf16_t* O; int ldc; float* ss;
    __device__ __forceinline__ void operator()(const f32x4 (&acc)[2][2][4][2], const Unit& u, int wr, int wc, int fr, int fq) const {
        const int row0 = u.pm * BM + wr * 64 + fr, col0 = u.pn * BM + wc * 32 + 8 * fq;
#pragma unroll
        for (int ai = 0; ai < 2; ++ai)
#pragma unroll
            for (int m = 0; m < 4; ++m) { const int row = row0 + ai * HALF + m * 16; float s = 0.f;
#pragma unroll
                for (int bj = 0; bj < 2; ++bj) { const f32x4 v0 = acc[ai][bj][m][0], v1 = acc[ai][bj][m][1];
                    s += (v0[0] * v0[0] + v0[1] * v0[1]) + (v0[2] * v0[2] + v0[3] * v0[3]) + (v1[0] * v1[0] + v1[1] * v1[1]) + (v1[2] * v1[2] + v1[3] * v1[3]);
                    u32x4 w; w.x = cvt_pk_bf16(v0[0], v0[1]); w.y = cvt_pk_bf16(v0[2], v0[3]); w.z = cvt_pk_bf16(v1[0], v1[1]); w.w = cvt_pk_bf16(v1[2], v1[3]);
                    __builtin_nontemporal_store(w, (u32x4*)(O + (size_t)row * ldc + col0 + bj * HALF)); }
                s += __shfl_xor(s, 16); s += __shfl_xor(s, 32);
                if (fq == 0) ss[(size_t)row * 16 + u.pn * 4 + wc] = s; }
    }
};
struct EpiScale {
    static constexpr bool PERM = true, AFTER_DRAIN = false;
    bf16_t* O; int ldc; const float* rs; float scale;
    __device__ __forceinline__ void operator()(const f32x4 (&acc)[2][2][4][2], const Unit& u, int wr, int wc, int fr, int fq) const {
        const int row0 = u.pm * BM + wr * 64 + fr, col0 = u.pn * BM + wc * 32 + 8 * fq;
#pragma unroll
        for (int ai = 0; ai < 2; ++ai)
#pragma unroll
            for (int m = 0; m < 4; ++m) { const int row = row0 + ai * HALF + m * 16; const float r = rs ? rs[row] * scale : scale;
#pragma unroll
                for (int bj = 0; bj < 2; ++bj) { const f32x4 v0 = acc[ai][bj][m][0] * r, v1 = acc[ai][bj][m][1] * r;
                    u32x4 w; w.x = cvt_pk_bf16(v0[0], v0[1]); w.y = cvt_pk_bf16(v0[2], v0[3]); w.z = cvt_pk_bf16(v1[0], v1[1]); w.w = cvt_pk_bf16(v1[2], v1[3]);
                    *(u32x4*)(O + (size_t)row * ldc + col0 + bj * HALF) = w; } }
    }
};
struct EpiInProj {
    static constexpr bool PERM = true, AFTER_DRAIN = false;
    bf16_t *MIX, *KV, *GQK, *GR; float* SMALL; float* FZT; const float* rs; float qscale;
    __device__ __forceinline__ void operator()(const f32x4 (&acc)[2][2][4][2], const Unit& u, int wr, int wc, int fr, int fq) const {
        const int row0 = u.pm * BM + wr * 64 + fr, pn = u.pn;
        if (pn == 12) {
            if (wc == 0 && fq < 3) {
#pragma unroll
                for (int ai = 0; ai < 2; ++ai)
#pragma unroll
                    for (int m = 0; m < 4; ++m) { const int row = row0 + ai * HALF + m * 16; const float r = rs[row];
                        const f32x4 v0 = acc[ai][0][m][0] * r, v1 = acc[ai][0][m][1] * r;
                        if (fq == 0) {
#pragma unroll
                            for (int c = 0; c < 4; ++c) { FZT[(size_t)c * 32768 + row] = v0[c]; FZT[(size_t)(c + 4) * 32768 + row] = v1[c]; } }
                        else { *(f32x4*)(SMALL + (size_t)row * 16 + 8 * (fq - 1)) = v0; *(f32x4*)(SMALL + (size_t)row * 16 + 8 * (fq - 1) + 4) = v1; } }
            }
            return;
        }
        bf16_t* base; int ldc, c0; float sc = 1.f;
        if (pn < 2) { base = MIX; ldc = 1024; c0 = pn * 256; sc = qscale; }
        else if (pn < 4) { base = KV; ldc = 1024; c0 = (pn - 2) * 256; }
        else if (pn < 6) { base = KV; ldc = 1024; c0 = 512 + (pn - 4) * 256; }
        else if (pn < 8) { base = GQK; ldc = 512; c0 = (pn - 6) * 256; }
        else if (pn < 10) { base = MIX; ldc = 1024; c0 = 512 + (pn - 8) * 256; }
        else { base = GR; ldc = 512; c0 = (pn - 10) * 256; }
        const int col0 = c0 + wc * 32 + 8 * fq;
#pragma unroll
        for (int ai = 0; ai < 2; ++ai)
#pragma unroll
            for (int m = 0; m < 4; ++m) { const int row = row0 + ai * HALF + m * 16; const float r = rs[row] * sc;
#pragma unroll
                for (int bj = 0; bj < 2; ++bj) { const f32x4 v0 = acc[ai][bj][m][0] * r, v1 = acc[ai][bj][m][1] * r;
                    u32x4 w; w.x = cvt_pk_bf16(v0[0], v0[1]); w.y = cvt_pk_bf16(v0[2], v0[3]); w.z = cvt_pk_bf16(v1[0], v1[1]); w.w = cvt_pk_bf16(v1[2], v1[3]);
                    *(u32x4*)(base + (size_t)row * ldc + col0 + bj * HALF) = w; } }
    }
};
struct OneUnit { int pm, pn; bool has;
    __device__ bool next(int i, Unit& u) const { if (i != 0 || !has) return false; u.pm = pm; u.pn = pn; return true; }
    __device__ __forceinline__ void a_ready(const Unit&) const {}
    __device__ __forceinline__ void done(const Unit&) const {} };
}

namespace cg = cooperative_groups;
#define LAS __attribute__((address_space(3)))
typedef unsigned short bf16;
typedef unsigned v4u __attribute__((ext_vector_type(4)));
typedef unsigned v2u __attribute__((ext_vector_type(2)));
typedef float f32x4 __attribute__((ext_vector_type(4)));
typedef short bf16x8 __attribute__((ext_vector_type(8)));

typedef __attribute__((address_space(1))) unsigned gu32;
#define XB_TMO      128
#define XB_XCNT(j)  (256  + 64 * (j))
#define XB_XSUB(j)  (1280 + 64 * (j))
#define XB_XGEN(j)  (2304 + 64 * (j))
#define XB_TOP      3328
#define XB_TOPGEN   3392
#define XCD_BAR_WORDS 3456
#define XB_SPIN_CAP (1u << 18)

__device__ __forceinline__ unsigned xb_ld(unsigned* p)              { return __hip_atomic_load(p, __ATOMIC_RELAXED, __HIP_MEMORY_SCOPE_AGENT); }
__device__ __forceinline__ unsigned xb_add(unsigned* p, unsigned v) { return __hip_atomic_fetch_add(p, v, __ATOMIC_RELAXED, __HIP_MEMORY_SCOPE_AGENT); }
__device__ __forceinline__ unsigned xb_xcc_id() { return (unsigned)__builtin_amdgcn_s_getreg((3 << 11) | 20) & 0xFu; }
#define XB_SPIN(cond, bar) do { unsigned _sp = 0; while (cond) { __builtin_amdgcn_s_sleep(1); \
    if ((++_sp & 255u) == 0u) { if (xb_ld(&(bar)[XB_TMO])) break; if (_sp > XB_SPIN_CAP) { atomicAdd(&(bar)[XB_TMO], 1u); break; } } } } while (0)

struct XcdBarrier {
    unsigned* bar; unsigned x;
    volatile LAS unsigned* st;
};

__device__ __forceinline__ XcdBarrier xcd_barrier_post(unsigned* bar, volatile LAS unsigned* st) {
    XcdBarrier b; b.bar = bar; b.x = xb_xcc_id(); b.st = st;
    if (threadIdx.x == 0) (void)xb_add(&bar[XB_XCNT(b.x)], 1u);
    return b;
}
__device__ __forceinline__ void xcd_barrier_complete(unsigned* bar, unsigned x, unsigned& nloc, unsigned& nx) {
    const unsigned G = gridDim.x * gridDim.y * gridDim.z;
    unsigned sum, cnt, mine, sp = 0u;
    for (;;) {
        sum = 0u; cnt = 0u; mine = 0u;
#pragma unroll
        for (unsigned j = 0; j < 16; ++j) { const unsigned c = xb_ld(&bar[XB_XCNT(j)]); sum += c; cnt += (c > 0u) ? 1u : 0u; mine = (j == x) ? c : mine; }
        if (sum == G) break;
        __builtin_amdgcn_s_sleep(1);
        if ((++sp & 255u) == 0u) { if (xb_ld(&bar[XB_TMO])) break; if (sp > XB_SPIN_CAP) { atomicAdd(&bar[XB_TMO], 1u); break; } }
    }
    nloc = mine > 0u ? mine : 1u; nx = cnt > 0u ? cnt : 1u;
}

__device__ __forceinline__ void xcd_barrier(const XcdBarrier& b) {
    asm volatile("s_waitcnt vmcnt(0)" ::: "memory");
    __syncthreads();
    if (threadIdx.x == 0) {
        unsigned* bar = b.bar;
        __builtin_amdgcn_s_waitcnt(0);
        unsigned nloc = b.st[0], nx = b.st[1];
        if (nloc == 0u) { xcd_barrier_complete(bar, b.x, nloc, nx); b.st[0] = nloc; b.st[1] = nx; }
        const unsigned old = xb_add(&bar[XB_XSUB(b.x)], 1u);
        const unsigned gen = old / nloc;
        if (old + 1u == (gen + 1u) * nloc) {
            __builtin_amdgcn_fence(__ATOMIC_RELEASE, "agent");
            asm volatile("s_waitcnt vmcnt(0)" ::: "memory");
            const unsigned og = xb_add(&bar[XB_TOP], 1u);
            const unsigned tg = og / nx;
            if (og + 1u == (tg + 1u) * nx) xb_add(&bar[XB_TOPGEN], 1u);
            else XB_SPIN(xb_ld(&bar[XB_TOPGEN]) == tg, bar);
            __builtin_amdgcn_fence(__ATOMIC_ACQUIRE, "agent");
            xb_add(&bar[XB_XGEN(b.x)], 1u);
            asm volatile("s_waitcnt vmcnt(0)" ::: "memory");
        } else {
            XB_SPIN(xb_ld(&bar[XB_XGEN(b.x)]) == gen, bar);
            __builtin_amdgcn_fence(__ATOMIC_ACQUIRE, "agent");
            asm volatile("s_waitcnt vmcnt(0)" ::: "memory");
        }
    }
    __syncthreads();
}

constexpr int NWAVES = 8, NTHR = 512;
constexpr int T = 32768, DM = 1024, SEQ = 8192, NB = 4, FF = 2816, NGU = 5632, NIN = 3328;
constexpr float EPS = 1e-6f, LOG2E = 1.4426950408889634f;
constexpr size_t MiB = 1u << 20;
constexpr size_t WS_CTL = 0, CTL_ZERO_BYTES = 65536;
constexpr int MISC_OFF = 147456 - 128;
constexpr size_t WS_WGU1 = 2 * MiB, WS_WD1 = 14 * MiB, WS_WIN = 20 * MiB, WS_WOUT = 27 * MiB, WS_WMQ = 29 * MiB, WS_WMKV = 31 * MiB, WS_WMO = 35 * MiB,
                 WS_WGU2 = 37 * MiB, WS_WD2 = 48 * MiB, WS_MEMN = 54 * MiB, WS_KM = 56 * MiB, WS_VT = 58 * MiB, WS_RSTD = 60 * MiB, WS_ROWSS = 61 * MiB,
                 WS_SMALL = 63 * MiB, WS_CF = 67 * MiB, WS_DEC = 68 * MiB, WS_UB = 69 * MiB, WS_XB = 70 * MiB, WS_FB = 134 * MiB, WS_GR = 198 * MiB, WS_SCH = 230 * MiB,
                 WS_ACT = 294 * MiB, WS_MIX = 294 * MiB, WS_KV = 358 * MiB, WS_GQK = 422 * MiB, WS_QM = 294 * MiB, WS_OM = 358 * MiB, WS_BCG = 470 * MiB, WS_END = 502 * MiB;
constexpr int LDS_BYTES = 147456;
constexpr int NPH = 17;

typedef float f32x2_ __attribute__((ext_vector_type(2))); typedef __bf16 bf16x2_ __attribute__((ext_vector_type(2)));
__device__ __forceinline__ unsigned pk2(float lo, float hi) { f32x2_ v = {lo, hi}; return __builtin_bit_cast(unsigned, __builtin_convertvector(v, bf16x2_)); }
__device__ __forceinline__ unsigned f2bf(float f) { return pk2(f, 0.f) & 0xffffu; }
__device__ __forceinline__ float bf2f(unsigned b) { return __builtin_bit_cast(float, b << 16); }
__device__ __forceinline__ float bflo(unsigned w) { return __builtin_bit_cast(float, w << 16); }
__device__ __forceinline__ float bfhi(unsigned w) { return __builtin_bit_cast(float, w & 0xffff0000u); }
__device__ __forceinline__ float wave_sum(float v) {
#pragma unroll
    for (int o = 1; o < 64; o <<= 1) v += __shfl_xor(v, o);
    return v;
}
__device__ __forceinline__ float logsig(float x) { return fminf(x, 0.f) - __logf(1.0f + __expf(-fabsf(x))); }
__device__ __forceinline__ float silu1(float x) { return x * __builtin_amdgcn_rcpf(1.0f + __builtin_amdgcn_exp2f(-LOG2E * x)); }

template <int MAP> __device__ __forceinline__ int src_col(int R) {
    if (MAP == 0) return R;
    if (MAP == 1) { const int pn = R >> 8, w = R & 255; return (w < 128) ? pn * 128 + w : FF + pn * 128 + (w - 128); }
    if (R < 1536) return R;
    if (R < 3072) return R + 8;
    if (R < 3080) return R - 1536;
    if (R < 3096) return R;
    return -1;
}
template <int MAP> __device__ __forceinline__ void transpose_item(const float* __restrict__ W, int ldn, int K, bf16* WT, const float* __restrict__ g, LAS float* scr, int item, int nblk, int lane) {
    const int kb = item / nblk, nb = item % nblk, k0 = 64 * kb, n0 = 64 * nb;
    const int cg = (lane & 15) * 4, sc = src_col<MAP>(n0 + cg);
    f32x4 v[16];
#pragma unroll
    for (int i = 0; i < 16; ++i) { const int kk = 4 * i + (lane >> 4); v[i] = (f32x4){0.f, 0.f, 0.f, 0.f}; if (sc >= 0) v[i] = __builtin_nontemporal_load((const f32x4*)(W + (size_t)(k0 + kk) * ldn + sc)); }
#pragma unroll
    for (int i = 0; i < 16; ++i) { const int kk = 4 * i + (lane >> 4); f32x4 t = v[i]; if (g) t = t * g[k0 + kk];
        scr[kk * 65 + cg] = t[0]; scr[kk * 65 + cg + 1] = t[1]; scr[kk * 65 + cg + 2] = t[2]; scr[kk * 65 + cg + 3] = t[3]; }
    asm volatile("s_waitcnt lgkmcnt(0)" ::: "memory");
    const int c = lane & 7;
#pragma unroll
    for (int j = 0; j < 8; ++j) { const int n = (lane >> 3) + 8 * j; const LAS float* s = scr + (8 * c) * 65 + n;
        v4u o; o.x = pk2(s[0 * 65], s[1 * 65]); o.y = pk2(s[2 * 65], s[3 * 65]); o.z = pk2(s[4 * 65], s[5 * 65]); o.w = pk2(s[6 * 65], s[7 * 65]);
        *(v4u*)(WT + (size_t)(n0 + n) * K + k0 + 8 * c) = o; }
    asm volatile("s_waitcnt lgkmcnt(0)" ::: "memory");
}

template <bool HOLD_BF, bool HAS_F, bool WR_H, bool WR_XB, int NR> __device__ __forceinline__ void row_update(const void* hold, const bf16* F, const float* ss16, const float* __restrict__ g, float w, float* hout, bf16* xb, float* rstd_out, int row0, int rstride, int lane) {
    f32x4 v[NR][4]; v2u fv[NR][4]; float ssv[NR];
#pragma unroll
    for (int r = 0; r < NR; ++r) { const int row = row0 + r * rstride;
        if (HOLD_BF) { const v2u* hb = (const v2u*)((const bf16*)hold + (size_t)row * DM) + lane;
#pragma unroll
            for (int j = 0; j < 4; ++j) { const v2u t = hb[64 * j]; v[r][j] = (f32x4){bflo(t.x), bfhi(t.x), bflo(t.y), bfhi(t.y)}; } }
        else { const f32x4* hr = (const f32x4*)((const float*)hold + (size_t)row * DM) + lane;
#pragma unroll
            for (int j = 0; j < 4; ++j) v[r][j] = __builtin_nontemporal_load(hr + 64 * j); }
        if (HAS_F) { ssv[r] = ss16[(size_t)row * 16 + (lane & 15)]; const v2u* fr = (const v2u*)(F + (size_t)row * DM) + lane;
#pragma unroll
            for (int j = 0; j < 4; ++j) fv[r][j] = __builtin_nontemporal_load(fr + 64 * j); } }
    f32x4 gv[4];
    if (HAS_F) { const f32x4* gr = (const f32x4*)g + lane;
#pragma unroll
        for (int j = 0; j < 4; ++j) gv[j] = gr[64 * j]; }
#pragma unroll
    for (int r = 0; r < NR; ++r) { const int row = row0 + r * rstride;
        if (HAS_F) {
            float s = ssv[r];
            s += __shfl_xor(s, 1); s += __shfl_xor(s, 2); s += __shfl_xor(s, 4); s += __shfl_xor(s, 8);
            const float rf = w / sqrtf(s * (1.f / DM) + EPS);
#pragma unroll
            for (int j = 0; j < 4; ++j) { const v2u f = fv[r][j];
                v[r][j].x += bflo(f.x) * rf * gv[j].x; v[r][j].y += bfhi(f.x) * rf * gv[j].y; v[r][j].z += bflo(f.y) * rf * gv[j].z; v[r][j].w += bfhi(f.y) * rf * gv[j].w; }
        }
        if (WR_H) { f32x4* ho = (f32x4*)(hout + (size_t)row * DM) + lane;
#pragma unroll
            for (int j = 0; j < 4; ++j) __builtin_nontemporal_store(v[r][j], ho + 64 * j); }
        if (WR_XB) {
            float s2 = 0.f;
#pragma unroll
            for (int j = 0; j < 4; ++j) s2 += (v[r][j].x * v[r][j].x + v[r][j].y * v[r][j].y) + (v[r][j].z * v[r][j].z + v[r][j].w * v[r][j].w);
            s2 = wave_sum(s2);
            if (lane == 0) rstd_out[row] = 1.f / sqrtf(s2 * (1.f / DM) + EPS);
            v2u* xo = (v2u*)(xb + (size_t)row * DM) + lane;
#pragma unroll
            for (int j = 0; j < 4; ++j) { v2u o; o.x = pk2(v[r][j].x, v[r][j].y); o.y = pk2(v[r][j].z, v[r][j].w); xo[64 * j] = o; }
        }
    }
}
__device__ __forceinline__ void mem_row(const float* mem, const float* __restrict__ g, bf16* out, int row, int lane) {
    const f32x4* hr = (const f32x4*)(mem + (size_t)row * DM) + lane; const f32x4* gr = (const f32x4*)g + lane;
    f32x4 v[4]; float s2 = 0.f;
#pragma unroll
    for (int j = 0; j < 4; ++j) { v[j] = hr[64 * j]; s2 += (v[j].x * v[j].x + v[j].y * v[j].y) + (v[j].z * v[j].z + v[j].w * v[j].w); }
    const float r = 1.f / sqrtf(wave_sum(s2) * (1.f / DM) + EPS);
    v2u* xo = (v2u*)(out + (size_t)row * DM) + lane;
#pragma unroll
    for (int j = 0; j < 4; ++j) { const f32x4 gv = gr[64 * j]; v2u o; o.x = pk2(v[j].x * r * gv.x, v[j].y * r * gv.y); o.y = pk2(v[j].z * r * gv.z, v[j].w * r * gv.w); xo[64 * j] = o; }
}

__device__ __forceinline__ float ss8(v4u w) { float s = 0.f; const unsigned a[4] = {w.x, w.y, w.z, w.w};
#pragma unroll
    for (int e = 0; e < 4; ++e) { const float lo = bflo(a[e]), hi = bfhi(a[e]); s += lo * lo + hi * hi; } return s; }
__device__ __forceinline__ void fox_cumsum_unit(LAS float* scr, const float* SMALL, const float* b_f, float* CF, int bh, int tid) {
    const int b = bh >> 3, h = bh & 7; const float bfv = b_f[h];
    const f32x4* src = (const f32x4*)(SMALL + (size_t)h * T + (size_t)b * SEQ + (size_t)tid * 16);
    float v[16]; float run = 0.f;
#pragma unroll
    for (int e4 = 0; e4 < 4; ++e4) { const f32x4 xv = src[e4];
#pragma unroll
        for (int e = 0; e < 4; ++e) { run += logsig(xv[e] + bfv); v[e4 * 4 + e] = run; } }
    scr[tid] = run; __syncthreads();
    for (int off = 1; off < NTHR; off <<= 1) { const float t = (tid >= off) ? scr[tid - off] : 0.f; __syncthreads(); scr[tid] += t; __syncthreads(); }
    const float pre = scr[tid] - run;
    float* o = CF + (size_t)bh * SEQ + tid * 16;
#pragma unroll
    for (int e = 0; e < 16; e += 4) *(f32x4*)(o + e) = (f32x4){v[e] + pre, v[e + 1] + pre, v[e + 2] + pre, v[e + 3] + pre};
    __syncthreads();
}
__device__ __forceinline__ void fox_norm_unit(LAS float* scr, const bf16* Q, const bf16* K, unsigned* NQ, unsigned* NK, int unit, int tid) {
    const int bh = unit >> 3, seg = unit & 7, b = bh >> 3, h = bh & 7;
    float mq = 0.f, mk = 0.f;
#pragma unroll 8
    for (int r0 = 0; r0 < 1024; r0 += 64) { const size_t row = (size_t)b * SEQ + seg * 1024 + r0 + (tid >> 3);
        float sq = ss8(*(const v4u*)(Q + row * 1024 + h * 64 + (tid & 7) * 8)), sk = ss8(*(const v4u*)(K + row * 1024 + h * 64 + (tid & 7) * 8));
        sq += __shfl_xor(sq, 1); sq += __shfl_xor(sq, 2); sq += __shfl_xor(sq, 4); sk += __shfl_xor(sk, 1); sk += __shfl_xor(sk, 2); sk += __shfl_xor(sk, 4);
        mq = fmaxf(mq, sq); mk = fmaxf(mk, sk); }
#pragma unroll
    for (int o = 1; o < 64; o <<= 1) { mq = fmaxf(mq, __shfl_xor(mq, o)); mk = fmaxf(mk, __shfl_xor(mk, o)); }
    if ((tid & 63) == 0) { atomicMax(NQ + bh, __builtin_bit_cast(unsigned, mq)); atomicMax(NK + bh, __builtin_bit_cast(unsigned, mk)); }
}

#define LBAR() asm volatile("s_waitcnt lgkmcnt(0)\n\ts_barrier" ::: "memory")
constexpr int GL_BC = 0  , GL_GA = 16640  , GL_SEG = 20736  , GL_QD = 22784  , GL_KD = 32000, GL_AM = 41216,
              GL_VT = 50432  , GL_SPT = 68864  , GL_RS = 87296  , GL_GRL = 87808  ;
constexpr int GLP = 72, GOP = 136;
__device__ __forceinline__ int swz16(int r, int c) { return r * 72 + ((((c >> 3) ^ (r >> 4)) & 7) << 3) + (c & 7); }
__device__ __forceinline__ int swz8(int r, int c) { return r * 72 + ((((c >> 3) ^ (r >> 3)) & 7) << 3) + (c & 7); }
struct GlaW { float w[16]; float ba; };
__device__ __forceinline__ void gla_load_w(GlaW& W, const float* __restrict__ w_a2, const float* __restrict__ b_a, int h, int d) {
#pragma unroll
    for (int r = 0; r < 16; ++r) W.w[r] = w_a2[r * 256 + h * 64 + d];
    W.ba = b_a[h * 64 + d];
}
__device__ __forceinline__ void gla_logdecay(LAS unsigned char* lds, const GlaW& W, int tid) {
    LAS float* Bc = (LAS float*)(lds + GL_BC); const LAS float* ga = (const LAS float*)(lds + GL_GA); LAS float* sg = (LAS float*)(lds + GL_SEG);
    const int d = tid & 63, seg = tid >> 6;
    float vals[8]; float run = 0.f;
    const LAS f32x4* gp = (const LAS f32x4*)(ga + seg * 128);
    f32x4 gq[2][4];
#pragma unroll
    for (int q = 0; q < 4; ++q) gq[0][q] = gp[q];
#pragma unroll
    for (int k = 0; k < 8; ++k) {
        if (k < 7) {
#pragma unroll
            for (int q = 0; q < 4; ++q) gq[(k + 1) & 1][q] = gp[4 * (k + 1) + q]; }
            float x = W.ba;
#pragma unroll
        for (int q = 0; q < 4; ++q) { const f32x4 gv = gq[k & 1][q]; x += gv[0] * W.w[4 * q] + gv[1] * W.w[4 * q + 1] + gv[2] * W.w[4 * q + 2] + gv[3] * W.w[4 * q + 3]; }
        run += logsig(x) * (1.f / 16.f); vals[k] = run;
        }
    sg[seg * 64 + d] = run;
    LBAR();
    float pre = 0.f;
#pragma unroll
    for (int s2 = 0; s2 < 8; ++s2) { const float t = sg[s2 * 64 + d]; pre += (s2 < seg) ? t : 0.f; }
#pragma unroll
    for (int k = 0; k < 8; ++k) Bc[(seg * 8 + k) * 65 + d] = vals[k] + pre;
    LBAR();
}
__device__ __forceinline__ void gla_put_vt(LAS unsigned char* lds, const v4u a, const v4u b, int tid) {
    LAS bf16* VTl = (LAS bf16*)(lds + GL_VT);
    const int i = tid >> 3, vg = tid & 7;
    const unsigned wv[8] = {a.x, a.y, a.z, a.w, b.x, b.y, b.z, b.w};
#pragma unroll
    for (int e = 0; e < 8; ++e) { VTl[swz16(vg * 16 + 2 * e, i)] = (bf16)(wv[e] & 0xffffu); VTl[swz16(vg * 16 + 2 * e + 1, i)] = (bf16)(wv[e] >> 16); }
}
#define GLA_UNIT(u) const int h = (u) & 3, n = ((u) >> 2) & 127, b = (u) >> 9, row0 = b * SEQ + n * 64, bh = b * 4 + h
__device__ __forceinline__ void gla_prep_phase(LAS unsigned char* lds, const float* SMALL, const float* w_a2, const float* b_a, const bf16* GQK, const bf16* MIX, float* SCH, float* DEC, float* BCG, int first, int G, int tid) {
    if (first >= 2048) return;
    const int lane = tid & 63, wv = tid >> 6, l15 = lane & 15, fq = lane >> 4;
    LAS float* Bc = (LAS float*)(lds + GL_BC); LAS float* ga = (LAS float*)(lds + GL_GA); LAS bf16* KTE = (LAS bf16*)(lds + GL_QD); LAS bf16* VTl = (LAS bf16*)(lds + GL_VT);
    struct GpPre { float ga[2]; v4u k, v[2]; }; GpPre PA, PB;
#define GLA_LOADP(P, u) do { GLA_UNIT(u); (void)bh; (void)n; P.ga[0] = SMALL[(size_t)row0 * 16 + tid]; P.ga[1] = SMALL[(size_t)row0 * 16 + 512 + tid]; \
        P.k = *(const v4u*)(GQK + (size_t)(row0 + (tid >> 3)) * 512 + 256 + h * 64 + (tid & 7) * 8); \
        const v4u* vs_ = (const v4u*)(MIX + (size_t)(row0 + (tid >> 3)) * 1024 + 512 + h * 128 + (tid & 7) * 16); P.v[0] = vs_[0]; P.v[1] = vs_[1]; } while (0)
    GLA_LOADP(PA, first); if (first + G < 2048) GLA_LOADP(PB, first + G);
    GlaW W; int hcur = first & 3; gla_load_w(W, w_a2, b_a, hcur, tid & 63);
#define GLA_PREP_BODY(P, U_, UN_) do { \
        GLA_UNIT(U_); \
        LAS unsigned char* lz = lds; asm volatile("" : "+v"(lz)); \
        LAS float* Bc = (LAS float*)(lz + GL_BC); LAS float* ga = (LAS float*)(lz + GL_GA); LAS bf16* KTE = (LAS bf16*)(lz + GL_QD); LAS bf16* VTl = (LAS bf16*)(lz + GL_VT); \
        if (h != hcur) { hcur = h; gla_load_w(W, w_a2, b_a, hcur, tid & 63); } \
        ga[tid] = P.ga[0]; ga[512 + tid] = P.ga[1]; \
        gla_put_vt(lz, P.v[0], P.v[1], tid); \
        const v4u kP = P.k; if ((UN_) < 2048) GLA_LOADP(P, UN_); \
        LBAR(); \
        gla_logdecay(lz, W, tid); \
        { const int i_ = tid >> 3, dg_ = tid & 7; const LAS float* bs_ = Bc + i_ * 65 + dg_ * 8; float* bd_ = BCG + ((size_t)(U_) * 64 + i_) * 64 + dg_ * 8; \
          __builtin_nontemporal_store(((f32x4){bs_[0], bs_[1], bs_[2], bs_[3]}), (f32x4*)bd_); __builtin_nontemporal_store(((f32x4){bs_[4], bs_[5], bs_[6], bs_[7]}), (f32x4*)(bd_ + 4)); } \
        { const int i = tid >> 3, dg = tid & 7; const unsigned kw[4] = {kP.x, kP.y, kP.z, kP.w}; \
_Pragma("unroll") \
          for (int e = 0; e < 4; ++e) { const int d = dg * 8 + 2 * e; \
              const float e0 = __expf(Bc[63 * 65 + d] - Bc[i * 65 + d]), e1 = __expf(Bc[63 * 65 + d + 1] - Bc[i * 65 + d + 1]); \
              KTE[swz8(d, i)] = (bf16)f2bf(bflo(kw[e]) * e0); KTE[swz8(d + 1, i)] = (bf16)f2bf(bfhi(kw[e]) * e1); } } \
        if (tid < 64) DEC[((size_t)bh * 128 + n) * 64 + tid] = __expf(Bc[63 * 65 + tid]); \
        LBAR(); \
        f32x4 acc[4]; \
_Pragma("unroll") \
        for (int mb = 0; mb < 4; ++mb) acc[mb] = (f32x4){0.f, 0.f, 0.f, 0.f}; \
        bf16x8 bfr_[2], afr_[2][4]; \
_Pragma("unroll") \
        for (int ks = 0; ks < 2; ++ks) { bfr_[ks] = *(const LAS bf16x8*)(VTl + swz16(16 * wv + l15, ks * 32 + 8 * fq)); \
_Pragma("unroll") \
            for (int mb = 0; mb < 4; ++mb) afr_[ks][mb] = *(const LAS bf16x8*)(KTE + swz8(16 * mb + l15, ks * 32 + 8 * fq)); } \
        __builtin_amdgcn_sched_barrier(0); \
_Pragma("unroll") \
        for (int ks = 0; ks < 2; ++ks) \
_Pragma("unroll") \
            for (int mb = 0; mb < 4; ++mb) acc[mb] = __builtin_amdgcn_mfma_f32_16x16x32_bf16(afr_[ks][mb], bfr_[ks], acc[mb], 0, 0, 0); \
        __builtin_amdgcn_sched_barrier(0); \
        float* dst = SCH + (((size_t)bh * 128 + n) * 64) * 128 + 16 * wv + l15; \
_Pragma("unroll") \
        for (int mb = 0; mb < 4; ++mb) \
_Pragma("unroll") \
            for (int j = 0; j < 4; ++j) __builtin_nontemporal_store(acc[mb][j], dst + (size_t)(16 * mb + 4 * fq + j) * 128); \
        LBAR(); \
    } while (0)
    for (int u = first; u < 2048; u += 2 * G) { GLA_PREP_BODY(PA, u, u + 2 * G); if (u + G < 2048) GLA_PREP_BODY(PB, u + G, u + 3 * G); }
#undef GLA_PREP_BODY
#undef GLA_LOADP
}
__device__ __forceinline__ void gla_out_phase(LAS unsigned char* lds, const float* BCG, const bf16* GQK, const bf16* MIX, bf16* OUT, const bf16* GR, const bf16* SCH, const float* __restrict__ g_gla, int first, int G, int tid) {
    if (first >= 2048) return;
    const int lane = tid & 63, wv = tid >> 6, l15 = lane & 15, fq = lane >> 4, mb = wv >> 1;
    LAS float* Bc = (LAS float*)(lds + GL_BC); LAS float* ga = (LAS float*)(lds + GL_GA); LAS bf16* QD = (LAS bf16*)(lds + GL_QD); LAS bf16* KD = (LAS bf16*)(lds + GL_KD); LAS bf16* AM = (LAS bf16*)(lds + GL_AM);
    LAS bf16* VTl = (LAS bf16*)(lds + GL_VT); LAS bf16* SPT = (LAS bf16*)(lds + GL_SPT); LAS float* RS = (LAS float*)(lds + GL_RS); LAS bf16* GRL = (LAS bf16*)(lds + GL_GRL); LAS bf16* OST = (LAS bf16*)(lds + GL_QD);
    struct GoPre { f32x4 bc[2]; v4u q, k, v[2], gr[2], s[2]; }; GoPre PA;
#define GLA_LOADP(P, u) do { GLA_UNIT(u); { const f32x4* bb_ = (const f32x4*)(BCG + ((size_t)(u) * 64 + (tid >> 3)) * 64 + (tid & 7) * 8); P.bc[0] = __builtin_nontemporal_load(bb_); P.bc[1] = __builtin_nontemporal_load(bb_ + 1); } \
        P.q = *(const v4u*)(GQK + (size_t)(row0 + (tid >> 3)) * 512 + h * 64 + (tid & 7) * 8); P.k = *(const v4u*)(GQK + (size_t)(row0 + (tid >> 3)) * 512 + 256 + h * 64 + (tid & 7) * 8); \
        const v4u* vs_ = (const v4u*)(MIX + (size_t)(row0 + (tid >> 3)) * 1024 + 512 + h * 128 + (tid & 7) * 16); P.v[0] = vs_[0]; P.v[1] = vs_[1]; \
        const v4u* gs_ = (const v4u*)(GR + (size_t)(row0 + (tid >> 3)) * 512 + h * 128 + (tid & 7) * 16); P.gr[0] = gs_[0]; P.gr[1] = gs_[1]; \
        const v4u* ss_ = (const v4u*)(SCH + (((size_t)bh * 128 + n) * 64 + (tid >> 3)) * 128 + (tid & 7) * 16); P.s[0] = __builtin_nontemporal_load(ss_); P.s[1] = __builtin_nontemporal_load(ss_ + 1); } while (0)
    GLA_LOADP(PA, first);
    int hcur = first & 3;
    float gg[4];
#pragma unroll
    for (int t4 = 0; t4 < 4; ++t4) gg[t4] = g_gla[hcur * 128 + 16 * ((wv & 1) * 4 + t4) + l15];
#define GLA_OUT_BODY(P, U_, UN_) do { \
        GLA_UNIT(U_); (void)bh; (void)n; \
        LAS unsigned char* lz = lds; asm volatile("" : "+v"(lz)); \
        LAS float* Bc = (LAS float*)(lz + GL_BC); LAS float* ga = (LAS float*)(lz + GL_GA); LAS bf16* QD = (LAS bf16*)(lz + GL_QD); LAS bf16* KD = (LAS bf16*)(lz + GL_KD); LAS bf16* AM = (LAS bf16*)(lz + GL_AM); \
        LAS bf16* VTl = (LAS bf16*)(lz + GL_VT); LAS bf16* SPT = (LAS bf16*)(lz + GL_SPT); LAS float* RS = (LAS float*)(lz + GL_RS); LAS bf16* GRL = (LAS bf16*)(lz + GL_GRL); LAS bf16* OST = (LAS bf16*)(lz + GL_QD); \
        if (h != hcur) { hcur = h; \
_Pragma("unroll") \
            for (int t4 = 0; t4 < 4; ++t4) gg[t4] = g_gla[hcur * 128 + 16 * ((wv & 1) * 4 + t4) + l15]; } \
        { LAS float* bw_ = Bc + (tid >> 3) * 65 + (tid & 7) * 8; bw_[0] = P.bc[0][0]; bw_[1] = P.bc[0][1]; bw_[2] = P.bc[0][2]; bw_[3] = P.bc[0][3]; bw_[4] = P.bc[1][0]; bw_[5] = P.bc[1][1]; bw_[6] = P.bc[1][2]; bw_[7] = P.bc[1][3]; } \
        gla_put_vt(lz, P.v[0], P.v[1], tid); \
        { const int d = tid >> 3, vg = tid & 7; \
          { const unsigned sw_[8] = {P.s[0].x, P.s[0].y, P.s[0].z, P.s[0].w, P.s[1].x, P.s[1].y, P.s[1].z, P.s[1].w}; \
_Pragma("unroll") \
            for (int e = 0; e < 8; ++e) { SPT[swz16(vg * 16 + 2 * e, d)] = (bf16)(sw_[e] & 0xffffu); SPT[swz16(vg * 16 + 2 * e + 1, d)] = (bf16)(sw_[e] >> 16); } } \
          *(LAS v4u*)(GRL + (tid >> 3) * GOP + vg * 16) = P.gr[0]; *(LAS v4u*)(GRL + (tid >> 3) * GOP + vg * 16 + 8) = P.gr[1]; } \
        const v4u qP = P.q, kP = P.k; if ((UN_) < 2048) GLA_LOADP(P, UN_); \
        LBAR(); \
        { const int i = tid >> 3, dg = tid & 7; \
          const unsigned qw[4] = {qP.x, qP.y, qP.z, qP.w}, kw[4] = {kP.x, kP.y, kP.z, kP.w}; \
          unsigned qo[4], ko[4]; \
_Pragma("unroll") \
          for (int e = 0; e < 4; ++e) { const int d = dg * 8 + 2 * e; const float b0 = Bc[i * 65 + d], b1 = Bc[i * 65 + d + 1]; \
              qo[e] = pk2(bflo(qw[e]) * 0.125f * __expf(b0), bfhi(qw[e]) * 0.125f * __expf(b1)); \
              ko[e] = pk2(bflo(kw[e]) * __expf(-b0), bfhi(kw[e]) * __expf(-b1)); } \
          *(LAS v4u*)(QD + i * GLP + dg * 8) = (v4u){qo[0], qo[1], qo[2], qo[3]}; \
          *(LAS v4u*)(KD + i * GLP + dg * 8) = (v4u){ko[0], ko[1], ko[2], ko[3]}; } \
        LBAR(); \
        bf16x8 qa_[2], kb_[2][2]; \
_Pragma("unroll") \
        for (int ks = 0; ks < 2; ++ks) { qa_[ks] = *(const LAS bf16x8*)(QD + (16 * mb + l15) * GLP + ks * 32 + 8 * fq); \
_Pragma("unroll") \
            for (int t2 = 0; t2 < 2; ++t2) kb_[t2][ks] = *(const LAS bf16x8*)(KD + (16 * ((wv & 1) * 2 + t2) + l15) * GLP + ks * 32 + 8 * fq); } \
        __builtin_amdgcn_sched_barrier(0); \
_Pragma("unroll") \
        for (int t2 = 0; t2 < 2; ++t2) { const int nbj = (wv & 1) * 2 + t2; f32x4 a = (f32x4){0.f, 0.f, 0.f, 0.f}; \
_Pragma("unroll") \
            for (int ks = 0; ks < 2; ++ks) a = __builtin_amdgcn_mfma_f32_16x16x32_bf16(qa_[ks], kb_[t2][ks], a, 0, 0, 0); \
_Pragma("unroll") \
            for (int j = 0; j < 4; ++j) { const int i = 16 * mb + 4 * fq + j, jj = 16 * nbj + l15; AM[i * GLP + jj] = (bf16)f2bf(jj <= i ? a[j] : 0.f); } } \
        LBAR(); \
        f32x4 acc[4]; \
_Pragma("unroll") \
        for (int t4 = 0; t4 < 4; ++t4) acc[t4] = (f32x4){0.f, 0.f, 0.f, 0.f}; \
_Pragma("unroll") \
        for (int ks = 0; ks < 2; ++ks) { bf16x8 fA, fQ, fV[4], fS[4]; \
            fA = *(const LAS bf16x8*)(AM + (16 * mb + l15) * GLP + ks * 32 + 8 * fq); fQ = *(const LAS bf16x8*)(QD + (16 * mb + l15) * GLP + ks * 32 + 8 * fq); \
_Pragma("unroll") \
            for (int t4 = 0; t4 < 4; ++t4) { const int nb = (wv & 1) * 4 + t4; \
                fV[t4] = *(const LAS bf16x8*)(VTl + swz16(16 * nb + l15, ks * 32 + 8 * fq)); fS[t4] = *(const LAS bf16x8*)(SPT + swz16(16 * nb + l15, ks * 32 + 8 * fq)); } \
            __builtin_amdgcn_sched_barrier(0); \
_Pragma("unroll") \
            for (int t4 = 0; t4 < 4; ++t4) { acc[t4] = __builtin_amdgcn_mfma_f32_16x16x32_bf16(fA, fV[t4], acc[t4], 0, 0, 0); acc[t4] = __builtin_amdgcn_mfma_f32_16x16x32_bf16(fQ, fS[t4], acc[t4], 0, 0, 0); } \
            __builtin_amdgcn_sched_barrier(0); } \
_Pragma("unroll") \
        for (int j = 0; j < 4; ++j) { float s = 0.f; \
_Pragma("unroll") \
            for (int t4 = 0; t4 < 4; ++t4) s += acc[t4][j] * acc[t4][j]; \
            s += __shfl_xor(s, 1); s += __shfl_xor(s, 2); s += __shfl_xor(s, 4); s += __shfl_xor(s, 8); \
            if (l15 == 0) RS[(16 * mb + 4 * fq + j) * 2 + (wv & 1)] = s; } \
        LBAR(); \
        float rs_[4][2]; bf16 gt_[4][4]; \
_Pragma("unroll") \
        for (int j = 0; j < 4; ++j) { const int i = 16 * mb + 4 * fq + j; rs_[j][0] = RS[i * 2]; rs_[j][1] = RS[i * 2 + 1]; \
_Pragma("unroll") \
            for (int t4 = 0; t4 < 4; ++t4) gt_[j][t4] = GRL[i * GOP + 16 * ((wv & 1) * 4 + t4) + l15]; } \
        __builtin_amdgcn_sched_barrier(0); \
_Pragma("unroll") \
        for (int j = 0; j < 4; ++j) { const int i = 16 * mb + 4 * fq + j; const float rinv = __builtin_amdgcn_rsqf((rs_[j][0] + rs_[j][1]) * (1.f / 128.f) + EPS); \
_Pragma("unroll") \
            for (int t4 = 0; t4 < 4; ++t4) { const int c = 16 * ((wv & 1) * 4 + t4) + l15; \
                OST[i * GOP + c] = (bf16)f2bf(acc[t4][j] * rinv * gg[t4] * silu1(bf2f(gt_[j][t4]))); } } \
        LBAR(); \
_Pragma("unroll") \
        for (int k = 0; k < 2; ++k) { const int c = tid + NTHR * k, r = c >> 4, ch = c & 15; \
            *(v4u*)(OUT + (size_t)(row0 + r) * 1024 + 512 + h * 128 + ch * 8) = *(const LAS v4u*)(OST + r * GOP + ch * 8); } \
    } while (0)
    for (int u = first; u < 2048; u += G) GLA_OUT_BODY(PA, u, u + G);
#undef GLA_OUT_BODY
#undef GLA_LOADP
}
#undef GLA_UNIT

constexpr int XA_STAGE = 69632  , XA_V = 32768, XA_VP = 72;
template <class Sched> __device__ __forceinline__ void xattn_phase(LAS unsigned char* lds, const bf16* QM, const bf16* KM, const bf16* VT, bf16* OM, const Sched& S, int tid) {
    pg8::Unit gu_;
#define XA_UNIT(idx) (S.next((idx) >> 1, gu_) ? (((gu_.pm >> 5) << 8) | (gu_.pn << 6) | (((gu_.pm & 31) << 1) + ((idx) & 1))) : -1)
    const int first = XA_UNIT(0);
    if (first < 0) return;
    const int lane = tid & 63, wv = tid >> 6, l15 = lane & 15, fq = lane >> 4;
    v4u pk[4], pv[4];
#define XA_LOAD(u, kt) do { const int h_ = ((u) >> 6) & 3, b_ = (u) >> 8; _Pragma("unroll") for (int i = 0; i < 4; ++i) { const int p = tid + NTHR * i; \
        pk[i] = *(const v4u*)(KM + (size_t)(b_ * 256 + (kt) * 64 + (p >> 5)) * 1024 + h_ * 256 + (p & 31) * 8); \
        pv[i] = *(const v4u*)(VT + (size_t)(h_ * 256 + (p >> 3)) * 1024 + b_ * 256 + (kt) * 64 + (p & 7) * 8); } } while (0)
#define XA_STORE(buf) do { LAS unsigned char* st_ = lds + (buf) * XA_STAGE; _Pragma("unroll") for (int i = 0; i < 4; ++i) { const int p = tid + NTHR * i; \
        *(LAS v4u*)(st_ + (p & 31) * 1024 + (p >> 5) * 16) = pk[i]; *(LAS v4u*)(st_ + XA_V + (p >> 3) * (XA_VP * 2) + (p & 7) * 16) = pv[i]; } } while (0)
    XA_LOAD(first, 0); XA_STORE(0);
    LBAR();
    int buf = 0;
    int unext = first;
    for (int idx = 0; unext >= 0; ++idx) {
        const int u = unext; unext = XA_UNIT(idx + 1);
        const int qblk = u & 63, h = (u >> 6) & 3, b = u >> 8;
        const int row0 = b * SEQ + qblk * 128 + wv * 16;
        bf16x8 qf[8];
#pragma unroll
        for (int s = 0; s < 8; ++s) qf[s] = *(const bf16x8*)(QM + (size_t)(row0 + l15) * 1024 + h * 256 + s * 32 + 8 * fq);
        float mrun = -1e30f, lrun = 0.f; f32x4 o[16];
#pragma unroll
        for (int db = 0; db < 16; ++db) o[db] = (f32x4){0.f, 0.f, 0.f, 0.f};
        for (int kt = 0; kt < 4; ++kt) {
            const bool more = (kt < 3) || (unext >= 0);
            if (more) { if (kt < 3) XA_LOAD(u, kt + 1); else XA_LOAD(unext, 0); }
            const LAS unsigned char* st = lds + buf * XA_STAGE;
            const LAS unsigned char* kbase = st + fq * 1024 + l15 * 16; const LAS unsigned char* vbase = st + XA_V + l15 * (XA_VP * 2) + 8 * fq;
#define XA_RDS(F, b) do { _Pragma("unroll") for (int kb = 0; kb < 4; ++kb) F[kb] = *(const LAS bf16x8*)(kbase + (b) * 4096 + kb * 256); } while (0)
#define XA_MMS(F, b) do { _Pragma("unroll") for (int kb = 0; kb < 4; ++kb) s[kb] = __builtin_amdgcn_mfma_f32_16x16x32_bf16(F[kb], qf[b], s[kb], 0, 0, 0); } while (0)
#define XA_RDV(F, b) do { _Pragma("unroll") for (int d4 = 0; d4 < 4; ++d4) { const LAS unsigned char* vp = vbase + (16 * (4 * ((b) & 3) + d4)) * (XA_VP * 2) + 64 * ((b) >> 2); \
        const v2u lo = *(const LAS v2u*)vp, hi = *(const LAS v2u*)(vp + 32); F[d4] = __builtin_bit_cast(bf16x8, ((v4u){lo.x, lo.y, hi.x, hi.y})); } } while (0)
#define XA_MMO(F, b) do { _Pragma("unroll") for (int d4 = 0; d4 < 4; ++d4) o[4 * ((b) & 3) + d4] = __builtin_amdgcn_mfma_f32_16x16x32_bf16(F[d4], pb[(b) >> 2], o[4 * ((b) & 3) + d4], 0, 0, 0); } while (0)
#define XA_SB() __builtin_amdgcn_sched_barrier(0)
            bf16x8 fa[4], fb[4];
            f32x4 s[4];
#pragma unroll
            for (int kb = 0; kb < 4; ++kb) s[kb] = (f32x4){0.f, 0.f, 0.f, 0.f};
            XA_RDS(fa, 0); XA_SB();
            XA_RDS(fb, 1); XA_SB(); XA_MMS(fa, 0); XA_SB();
            XA_RDS(fa, 2); XA_SB(); XA_MMS(fb, 1); XA_SB();
            XA_RDS(fb, 3); XA_SB(); XA_MMS(fa, 2); XA_SB();
            XA_RDS(fa, 4); XA_SB(); XA_MMS(fb, 3); XA_SB();
            XA_RDS(fb, 5); XA_SB(); XA_MMS(fa, 4); XA_SB();
            XA_RDS(fa, 6); XA_SB(); XA_MMS(fb, 5); XA_SB();
            XA_RDS(fb, 7); XA_SB(); XA_MMS(fa, 6); XA_SB();
            XA_RDV(fa, 0); XA_SB(); XA_MMS(fb, 7); XA_SB();
            float mx = fmaxf(fmaxf(fmaxf(s[0][0], s[0][1]), fmaxf(s[0][2], s[0][3])), fmaxf(fmaxf(s[1][0], s[1][1]), fmaxf(s[1][2], s[1][3])));
            mx = fmaxf(mx, fmaxf(fmaxf(fmaxf(s[2][0], s[2][1]), fmaxf(s[2][2], s[2][3])), fmaxf(fmaxf(s[3][0], s[3][1]), fmaxf(s[3][2], s[3][3]))));
            mx = fmaxf(mx, __shfl_xor(mx, 16)); mx = fmaxf(mx, __shfl_xor(mx, 32));
            const float mnew = fmaxf(mrun, mx), alpha = __builtin_amdgcn_exp2f(mrun - mnew); mrun = mnew;
            float psum = 0.f;
#pragma unroll
            for (int kb = 0; kb < 4; ++kb)
#pragma unroll
                for (int j = 0; j < 4; ++j) { s[kb][j] = __builtin_amdgcn_exp2f(s[kb][j] - mnew); psum += s[kb][j]; }
            lrun = lrun * alpha + psum;
#pragma unroll
            for (int db = 0; db < 16; ++db) o[db] *= alpha;
            bf16x8 pb[2];
#pragma unroll
            for (int g = 0; g < 2; ++g) { v4u pw; pw.x = pk2(s[2 * g][0], s[2 * g][1]); pw.y = pk2(s[2 * g][2], s[2 * g][3]); pw.z = pk2(s[2 * g + 1][0], s[2 * g + 1][1]); pw.w = pk2(s[2 * g + 1][2], s[2 * g + 1][3]);
                pb[g] = __builtin_bit_cast(bf16x8, pw); }
            XA_SB();
            XA_RDV(fb, 1); XA_SB(); XA_MMO(fa, 0); XA_SB();
            XA_RDV(fa, 2); XA_SB(); XA_MMO(fb, 1); XA_SB();
            XA_RDV(fb, 3); XA_SB(); XA_MMO(fa, 2); XA_SB();
            XA_RDV(fa, 4); XA_SB(); XA_MMO(fb, 3); XA_SB();
            XA_RDV(fb, 5); XA_SB(); XA_MMO(fa, 4); XA_SB();
            XA_RDV(fa, 6); XA_SB(); XA_MMO(fb, 5); XA_SB();
            XA_RDV(fb, 7); XA_SB(); XA_MMO(fa, 6); XA_SB();
            XA_MMO(fb, 7); XA_SB();
#undef XA_RDS
#undef XA_MMS
#undef XA_RDV
#undef XA_MMO
#undef XA_SB
            if (more) XA_STORE(buf ^ 1);
            LBAR();
            buf ^= 1;
        }
        lrun += __shfl_xor(lrun, 16); lrun += __shfl_xor(lrun, 32);
        const float rl = 1.f / lrun;
        bf16* orow = OM + (size_t)(row0 + l15) * 1024 + h * 256 + 4 * fq;
#pragma unroll
        for (int db = 0; db < 16; ++db) { v2u w; w.x = pk2(o[db][0] * rl, o[db][1] * rl); w.y = pk2(o[db][2] * rl, o[db][3] * rl); *(v2u*)(orow + 16 * db) = w; }
    }
#undef XA_LOAD
#undef XA_STORE
#undef XA_UNIT
}

struct Args { const float* in[24]; float* out; unsigned char* ws; int ph_lo, ph_hi; };
__global__ void __launch_bounds__(NTHR, 2) layer_fwd(Args args) {
    extern __shared__ __attribute__((aligned(16))) unsigned char lds_raw[];
    LAS unsigned char* lds = (LAS unsigned char*)lds_raw;
    const int tid = threadIdx.x, lane = tid & 63, wave = __builtin_amdgcn_readfirstlane(tid >> 6);
    const int G = gridDim.x, bx = blockIdx.x;
    const int vcu = (G % 8 == 0) ? (bx % 8) * (G / 8) + bx / 8 : bx;
    const int gw = vcu * NWAVES + wave, NGW = G * NWAVES;
    unsigned char* ws = args.ws;
    bf16 *W_GU1 = (bf16*)(ws + WS_WGU1), *W_D1 = (bf16*)(ws + WS_WD1), *W_IN = (bf16*)(ws + WS_WIN), *W_OUT = (bf16*)(ws + WS_WOUT), *W_MQ = (bf16*)(ws + WS_WMQ), *W_MKV = (bf16*)(ws + WS_WMKV),
         *W_MO = (bf16*)(ws + WS_WMO), *W_GU2 = (bf16*)(ws + WS_WGU2), *W_D2 = (bf16*)(ws + WS_WD2), *MEMN = (bf16*)(ws + WS_MEMN), *KM = (bf16*)(ws + WS_KM), *VTm = (bf16*)(ws + WS_VT),
         *XB = (bf16*)(ws + WS_XB), *FB = (bf16*)(ws + WS_FB), *GR = (bf16*)(ws + WS_GR), *ACT = (bf16*)(ws + WS_ACT), *MIX = (bf16*)(ws + WS_MIX), *KV = (bf16*)(ws + WS_KV), *GQK = (bf16*)(ws + WS_GQK),
         *QM = (bf16*)(ws + WS_QM), *OM = (bf16*)(ws + WS_OM);
    float *RSTD = (float*)(ws + WS_RSTD), *ROWSS = (float*)(ws + WS_ROWSS), *SMALL = (float*)(ws + WS_SMALL), *CF = (float*)(ws + WS_CF), *DEC = (float*)(ws + WS_DEC), *SCH = (float*)(ws + WS_SCH), *UB = (float*)(ws + WS_UB), *FZT = SMALL + (size_t)T * 16, *BCG = (float*)(ws + WS_BCG); unsigned* NQK = (unsigned*)(ws + WS_CTL) + 8192;
    const int lo = args.ph_lo, hi = args.ph_hi;
    volatile LAS unsigned* MISC = (volatile LAS unsigned*)(lds + MISC_OFF);
    if (tid < 32) MISC[tid] = 0u;
    __syncthreads();
    (void)xcd_barrier_post((unsigned*)(ws + WS_CTL) + 1024, MISC + 8);
    if (hi > NPH) cg::this_grid().sync();
#define IN(k) (lo <= (k) && (k) < hi)
#ifndef PROBE
#define PROBE 0
#endif
#ifndef GEMM_ALIGN
#define GEMM_ALIGN true
#endif
#ifndef GEMM_SP2
#define GEMM_SP2 true
#endif
#ifndef GU_ALIGN
#define GU_ALIGN true
#endif
#define PRB(n) (PROBE == (n))
#define REP(n) for (int rep_ = 0; rep_ < (PRB(n) ? 2 : 1); ++rep_)
#define SEAM(k) do { if (IN(k) && IN((k) + 1)) { XcdBarrier b_; b_.bar = (unsigned*)(args.ws + WS_CTL) + 1024; b_.x = xb_xcc_id(); b_.st = (volatile LAS unsigned*)(lds + MISC_OFF) + 8; xcd_barrier(b_); if (PRB(1)) xcd_barrier(b_); } } while (0)

    if (IN(0)) REP(4) {
        LAS float* scr = (LAS float*)(lds + wave * 17408);
        constexpr int I_GU = (DM / 64) * (NGU / 64), I_D = (FF / 64) * (DM / 64), I_IN = (DM / 64) * (NIN / 64), I_SQ = (DM / 64) * (DM / 64), I_KV = (DM / 64) * (2048 / 64);
        constexpr int NITEMS = I_GU + I_D + I_IN + I_KV;
        for (int r12 = 0; r12 < (PRB(12) ? 2 : 1); ++r12)
        for (int it = gw; it < NITEMS; it += NGW) {
            int r = it;
            if (r < I_GU) { transpose_item<1>(args.in[3], NGU, DM, W_GU1, args.in[2], scr, r, NGU / 64, lane); continue; } r -= I_GU;
            if (r < I_D) { transpose_item<0>(args.in[4], DM, FF, W_D1, nullptr, scr, r, DM / 64, lane); continue; } r -= I_D;
            if (r < I_IN) { transpose_item<2>(args.in[7], 3096, DM, W_IN, args.in[6], scr, r, NIN / 64, lane); continue; } r -= I_IN;
            transpose_item<0>(args.in[17], 2048, DM, W_MKV, nullptr, scr, r, 2048 / 64, lane);
        }
        for (int r13 = 0; r13 < (PRB(13) ? 2 : 1); ++r13)
        for (int m = gw; m < T; m += 4 * NGW) row_update<false, false, false, true, 4>(args.in[0], nullptr, nullptr, nullptr, 0.f, nullptr, XB, RSTD, m, NGW, lane);
        for (int m = gw; m < 1024; m += NGW) mem_row(args.in[1], args.in[15], MEMN, m, lane);
    }
    SEAM(0);
    if (IN(1)) REP(6) { pg8::Gemm g{XB, W_GU1, T, NGU, DM}; pg8::StaticOrder S; S.init(T, NGU, G, bx); pg8::EpiSwiGLU E{ACT, FF, RSTD};
        pg8::gemm_phase<pg8::EpiSwiGLU, pg8::StaticOrder, GU_ALIGN, GEMM_SP2>(lds, g, S, E); }
    SEAM(1);
    if (IN(2)) REP(6) { pg8::Gemm g{ACT, W_D1, T, DM, FF}; pg8::StaticOrder S; S.init(T, DM, G, bx); pg8::EpiRowSS E{FB, DM, ROWSS};
        pg8::gemm_phase<pg8::EpiRowSS, pg8::StaticOrder, GEMM_ALIGN, GEMM_SP2>(lds, g, S, E); }
    SEAM(2);
    if (IN(3)) REP(10) { for (int m = gw; m < T; m += 4 * NGW) row_update<false, true, false, true, 4>(args.in[0], FB, ROWSS, args.in[5], 0.5f, nullptr, XB, RSTD, m, NGW, lane); }
    SEAM(3);
    if (IN(4)) { pg8::Gemm g{XB, W_IN, T, NIN, DM}; pg8::StaticOrder S; S.init(T, NIN, G, bx); pg8::EpiInProj E{MIX, KV, GQK, GR, SMALL, FZT, RSTD, 0.125f * LOG2E};
        pg8::gemm_phase<pg8::EpiInProj, pg8::StaticOrder, GEMM_ALIGN, GEMM_SP2>(lds, g, S, E);
        const int nu4 = (T / 256) * (NIN / 256), slot = (nu4 % G) ? bx - (nu4 % G) : bx;
        { const bool mine = slot >= 0 && slot < 16; pg8::Gemm gk{MEMN, W_MKV, 1024, DM, DM}; pg8::OneUnit S1{mine ? slot >> 2 : 0, mine ? slot & 3 : 0, mine}; pg8::EpiScale Ek{KM, DM, nullptr, 1.f};
          pg8::gemm_phase<pg8::EpiScale, pg8::OneUnit, true, true>(lds, gk, S1, Ek); }
        { const bool mine = slot >= 16 && slot < 32; pg8::Gemm gv{W_MKV + (size_t)1024 * DM, MEMN, 1024, 1024, DM}; pg8::OneUnit S2{mine ? (slot - 16) >> 2 : 0, mine ? (slot - 16) & 3 : 0, mine}; pg8::EpiScale Ev{VTm, 1024, nullptr, 1.f};
          pg8::gemm_phase<pg8::EpiScale, pg8::OneUnit, true, true>(lds, gv, S2, Ev); }
        { const int nidle = (nu4 % G) ? G - (nu4 % G) - 32 : 0, rank = slot - 32;
          if (nidle > 0 && rank >= 0) {
              LAS float* scr = (LAS float*)(lds + wave * 17408);
              constexpr int I_GU = (DM / 64) * (NGU / 64), I_D = (FF / 64) * (DM / 64), I_SQ = (DM / 64) * (DM / 64);
              for (int it = rank * NWAVES + wave; it < I_GU + I_D + 3 * I_SQ; it += nidle * NWAVES) {
                  int r = it;
                  if (r < I_GU) { transpose_item<1>(args.in[21], NGU, DM, W_GU2, args.in[20], scr, r, NGU / 64, lane); continue; } r -= I_GU;
                  if (r < I_D) { transpose_item<0>(args.in[22], DM, FF, W_D2, nullptr, scr, r, DM / 64, lane); continue; } r -= I_D;
                  if (r < I_SQ) { transpose_item<0>(args.in[12], DM, DM, W_OUT, nullptr, scr, r, DM / 64, lane); continue; } r -= I_SQ;
                  if (r < I_SQ) { transpose_item<0>(args.in[16], DM, DM, W_MQ, args.in[14], scr, r, DM / 64, lane); continue; } r -= I_SQ;
                  transpose_item<0>(args.in[18], DM, DM, W_MO, nullptr, scr, r, DM / 64, lane);
              }
          }
        }
    }
    SEAM(4);
    if (IN(5)) REP(2) {
        for (int r9 = 0; r9 < (PRB(9) ? 2 : 1); ++r9) {
        for (int u = bx; u < 256; u += G) fox_norm_unit((LAS float*)lds, MIX, KV, NQK, NQK + 32, u, tid);
        for (int u = bx; u < 32; u += G) fox_cumsum_unit((LAS float*)lds, FZT, args.in[10], CF, u, tid);
        }
        for (int r7 = 0; r7 < (PRB(7) ? 2 : 1); ++r7) { gla_prep_phase(lds, SMALL, args.in[8], args.in[9], GQK, MIX, SCH, DEC, BCG, bx, G, tid); __syncthreads(); }
    }
    SEAM(5);
    if (IN(6)) {
        for (int r11 = 0; r11 < (PRB(11) ? 2 : 1); ++r11)
        for (size_t e = (size_t)bx * NTHR + tid; e < (size_t)16 * 8192; e += (size_t)G * NTHR) {
            const int bh = (int)(e >> 13), dv = (int)(e & 8191), d = dv >> 7;
            const float* p = SCH + (size_t)bh * 128 * 8192 + dv; bf16* po = FB + (size_t)bh * 128 * 8192 + dv; const float* dc = DEC + (size_t)bh * 128 * 64 + d;
            float st = 0.f;
            for (int n0 = 0; n0 < 128; n0 += 16) { float tv[16], dd[16];
#pragma unroll
                for (int k = 0; k < 16; ++k) { tv[k] = __builtin_nontemporal_load(p + (size_t)(n0 + k) * 8192); dd[k] = dc[(n0 + k) * 64]; }
#pragma unroll
                for (int k = 0; k < 16; ++k) { __builtin_nontemporal_store((bf16)f2bf(st), po + (size_t)(n0 + k) * 8192); st = dd[k] * st + tv[k]; } }
        }
        __syncthreads();
        REP(5) {
        const attn_body::AttnTensors AT{(const attn_body::bf16*)MIX, (const attn_body::bf16*)KV, (const attn_body::bf16*)(KV + 512), (attn_body::bf16*)(PRB(5) && rep_ == 0 ? FB : MIX), CF, (const float*)NQK};
        const attn_body::StaticOrder S(G, bx);
        attn_body::attn_phase<attn_body::StaticOrder>((char*)lds_raw, AT, S);
        }
    }
    SEAM(6);
    if (IN(7)) for (int rep_ = 0; rep_ < ((PRB(2) || PRB(8)) ? 2 : 1); ++rep_) { gla_out_phase(lds, BCG, GQK, MIX, (PRB(2) || PRB(8)) && rep_ == 0 ? KV : MIX, GR, (const bf16*)FB, args.in[11], bx, G, tid); __syncthreads(); }
    SEAM(7);
    if (IN(8)) { pg8::Gemm g{MIX, W_OUT, T, DM, DM}; pg8::StaticOrder S; S.init(T, DM, G, bx); pg8::EpiRowSS E{FB, DM, ROWSS};
        pg8::gemm_phase<pg8::EpiRowSS, pg8::StaticOrder, GEMM_ALIGN, GEMM_SP2>(lds, g, S, E); }
    SEAM(8);
    if (IN(9)) { for (int m = gw; m < T; m += 4 * NGW) row_update<true, true, false, true, 4>(XB, FB, ROWSS, args.in[13], 1.0f, nullptr, XB, RSTD, m, NGW, lane); }
    SEAM(9);
    if (IN(10)) {
        { pg8::Gemm g{XB, W_MQ, T, DM, DM}; pg8::StaticOrder S; S.init(T, DM, G, bx); pg8::EpiScale E{QM, DM, RSTD, (1.f / 16.f) * LOG2E};
          pg8::gemm_phase<pg8::EpiScale, pg8::StaticOrder, GEMM_ALIGN, GEMM_SP2>(lds, g, S, E);
          xattn_phase(lds, QM, KM, VTm, OM, S, tid); __syncthreads(); }
    }
    SEAM(11);
    if (IN(12)) { pg8::Gemm g{OM, W_MO, T, DM, DM}; pg8::StaticOrder S; S.init(T, DM, G, bx); pg8::EpiRowSS E{FB, DM, ROWSS};
        pg8::gemm_phase<pg8::EpiRowSS, pg8::StaticOrder, GEMM_ALIGN, GEMM_SP2>(lds, g, S, E); }
    SEAM(12);
    if (IN(13)) { for (int m = gw; m < T; m += 4 * NGW) row_update<true, true, false, true, 4>(XB, FB, ROWSS, args.in[19], 1.0f, nullptr, XB, RSTD, m, NGW, lane); }
    SEAM(13);
    if (IN(14)) { pg8::Gemm g{XB, W_GU2, T, NGU, DM}; pg8::StaticOrder S; S.init(T, NGU, G, bx); pg8::EpiSwiGLU E{ACT, FF, RSTD};
        pg8::gemm_phase<pg8::EpiSwiGLU, pg8::StaticOrder, GU_ALIGN, GEMM_SP2>(lds, g, S, E); }
    SEAM(14);
    if (IN(15)) { pg8::Gemm g{ACT, W_D2, T, DM, FF}; pg8::StaticOrder S; S.init(T, DM, G, bx); pg8::EpiRowSS E{FB, DM, ROWSS};
        pg8::gemm_phase<pg8::EpiRowSS, pg8::StaticOrder, GEMM_ALIGN, GEMM_SP2>(lds, g, S, E); }
    SEAM(15);
    if (IN(16)) { for (int m = gw; m < T; m += 4 * NGW) row_update<true, true, true, false, 4>(XB, FB, ROWSS, args.in[23], 0.5f, args.out, nullptr, nullptr, m, NGW, lane); }
#undef IN
#undef SEAM
}

#ifndef MK_N_LAUNCHES
#define MK_N_LAUNCHES 1
#endif
extern "C" void kernel_launch(void* const* d_in, const int* in_sizes, int n_in, void* d_out, int out_size, void* d_ws, size_t ws_size, hipStream_t stream) {
    static int grid = 0;
    if (grid == 0) {
        if (n_in != 24 || in_sizes[0] != T * DM || out_size != T * DM || ws_size < WS_END) { fprintf(stderr, "kernel_launch: unexpected shapes (n_in %d, in0 %d, out %d, ws %zu); nothing launched\n", n_in, n_in > 0 ? in_sizes[0] : -1, out_size, ws_size); grid = -1; return; }
        int dev = 0, cus = 0, per_cu = 0;
        if (hipGetDevice(&dev) != hipSuccess || hipDeviceGetAttribute(&cus, hipDeviceAttributeMultiprocessorCount, dev) != hipSuccess) { grid = -1; return; }
        if (hipFuncSetAttribute((const void*)layer_fwd, hipFuncAttributeMaxDynamicSharedMemorySize, LDS_BYTES) != hipSuccess) { fprintf(stderr, "kernel_launch: hipFuncSetAttribute failed\n"); grid = -1; return; }
        if (hipOccupancyMaxActiveBlocksPerMultiprocessor(&per_cu, (const void*)layer_fwd, NTHR, LDS_BYTES) != hipSuccess || per_cu < 1) { fprintf(stderr, "kernel_launch: occupancy query says %d\n", per_cu); per_cu = 1; }
        (void)hipGetLastError();
        grid = cus * per_cu;
        if (grid < 256) { fprintf(stderr, "kernel_launch: this kernel is laid out for 256 co-resident workgroups (one per CU); the device offers %d\n", grid); grid = -1; return; }
        grid = 256;
    }
    if (grid < 0) return;
    if (hipMemsetAsync((char*)d_ws + WS_CTL, 0, CTL_ZERO_BYTES, stream) != hipSuccess) { fprintf(stderr, "kernel_launch: memset failed\n"); return; }
    Args a{};
    for (int i = 0; i < 24; ++i) a.in[i] = (const float*)d_in[i];
    a.out = (float*)d_out; a.ws = (unsigned char*)d_ws;
#if MK_N_LAUNCHES == 1
    a.ph_lo = 0; a.ph_hi = NPH;
    void* kargs[] = {&a};
    hipError_t e = hipLaunchCooperativeKernel((const void*)layer_fwd, dim3(grid), dim3(NTHR), kargs, LDS_BYTES, stream);
    if (e != hipSuccess) fprintf(stderr, "kernel_launch: cooperative launch failed: %s (grid %d)\n", hipGetErrorString(e), grid);
#else
    for (int p = 0; p < NPH; ++p) { a.ph_lo = p; a.ph_hi = p + 1; hipLaunchKernelGGL(layer_fwd, dim3(grid), dim3(NTHR), LDS_BYTES, stream, a); }
#endif
}
```

```cpp
#include <hip/hip_runtime.h>
#include <hip/hip_cooperative_groups.h>
#include <cstdio>
#include <cstdint>
namespace pg8 {
#define PG8_LAS __attribute__((address_space(3)))
typedef unsigned short bf16_t;
typedef short bf16x8 __attribute__((ext_vector_type(8)));
typedef float f32x4 __attribute__((ext_vector_type(4)));
typedef unsigned u32x4 __attribute__((ext_vector_type(4)));
constexpr int BM = 256, BK = 64, HALF = 128, HTB = HALF * BK * 2  , STAGE_BYTES = 8 * HTB, NXCD = 8, WGM = 2;

__host__ __device__ __forceinline__ int lds_byte(int r, int c) { const int st = (r >> 4) * 2 + (c >> 5), rr = r & 15, cc = c & 31, ob = rr * 64 + cc * 2; return st * 1024 + (ob ^ (((ob >> 9) & 1) << 5)); }
__host__ __device__ __forceinline__ void stage_rc(int b, int& R, int& C) { const int st = b / 1024, sb = b % 1024, swz = sb ^ (((sb >> 9) & 1) << 5); R = (st >> 1) * 16 + swz / 64; C = (st & 1) * 32 + (swz % 64) / 2; }
__host__ __device__ __forceinline__ int perm32(int rho) { const int n = rho >> 4, i = rho & 15; return 8 * (i >> 2) + 4 * n + (i & 3); }

struct Unit { int pm, pn; };
struct Gemm { const bf16_t* A; const bf16_t* Bt; int M, N, K; };

struct StaticOrder {
    int nM, nN, nwg, G, c;
    __host__ __device__ void init(int M, int N, int G_, int c_) { nM = M / BM; nN = N / BM; nwg = nM * nN; G = G_; c = c_; }
    __host__ __device__ bool next(int i, Unit& u) const {
        const long L = (long)i * G + c; if (L >= nwg) return false;
        int wgid = (int)L; { const int q = nwg / NXCD, r = nwg % NXCD, xcd = wgid % NXCD, off = wgid / NXCD; wgid = (xcd < r ? xcd * (q + 1) : r * (q + 1) + (xcd - r) * q) + off; }
        const int nig = WGM * nN, gid = wgid / nig, fm = gid * WGM, gsz = (nM - fm) < WGM ? (nM - fm) : WGM;
        u.pm = fm + ((wgid % nig) % gsz); u.pn = (wgid % nig) / gsz; return true;
    }
    __device__ __forceinline__ void a_ready(const Unit&) const {}
    __device__ __forceinline__ void done(const Unit&) const {}
};

__device__ __forceinline__ unsigned cvt_pk_bf16(float lo, float hi) { unsigned r; asm volatile("v_cvt_pk_bf16_f32 %0, %1, %2" : "=v"(r) : "v"(lo), "v"(hi)); return r; }
typedef float f32x2 __attribute__((ext_vector_type(2)));
__device__ __forceinline__ f32x2 gelu_pk(f32x2 v) {
    const f32x2 av = __builtin_elementwise_abs(v), d = av * 0.2316418882f + 1.0f;
    f32x2 t; t.x = __builtin_amdgcn_rcpf(d.x); t.y = __builtin_amdgcn_rcpf(d.y);
    f32x2 q = t * 0.5307027145f + (-0.7265760135f); q = q * t + 0.7107068705f; q = q * t + (-0.142248368f); q = q * t + 0.127414796f; q = q * t;
    const f32x2 s = (v * v) * (-0.72134752044f);
    f32x2 e; e.x = __builtin_amdgcn_exp2f(s.x); e.y = __builtin_amdgcn_exp2f(s.y);
    const f32x2 m = v * (q * e), r = v - m;
    f32x2 o; o.x = v.x < 0.f ? m.x : r.x; o.y = v.y < 0.f ? m.y : r.y; return o;
}

template <int ACT  > struct EpiBf16 {
    static constexpr bool PERM = true, AFTER_DRAIN = false; static_assert(ACT == 0 || ACT == 1, "EpiBf16: ACT is 0 (none) or 1 (gelu_pk)");
    bf16_t* O; int ldc; const float* bias; int split_cols; size_t split_stride; float scale0;
    __device__ __forceinline__ void operator()(const f32x4 (&acc)[2][2][4][2], const Unit& u, int wr, int wc, int fr, int fq) const {
        const int row0 = u.pm * BM + wr * 64 + fr; int colt = u.pn * BM; bf16_t* base = O;
        float sc = 1.f; if (split_cols) { const int t = colt / split_cols; base += (size_t)t * split_stride; colt -= t * split_cols; if (t == 0) sc = scale0; }
        const int col0 = colt + wc * 32 + 8 * fq, bcol0 = u.pn * BM + wc * 32 + 8 * fq;
        f32x4 bv[2][2];
#pragma unroll
        for (int bj = 0; bj < 2; ++bj)
#pragma unroll
            for (int n = 0; n < 2; ++n) bv[bj][n] = bias ? *(const f32x4*)(bias + bcol0 + bj * HALF + 4 * n) : (f32x4){0.f, 0.f, 0.f, 0.f};
#pragma unroll
        for (int ai = 0; ai < 2; ++ai)
#pragma unroll
            for (int m = 0; m < 4; ++m) { bf16_t* rowp = base + (size_t)(row0 + ai * HALF + m * 16) * ldc + col0;
#pragma unroll
                for (int bj = 0; bj < 2; ++bj) { f32x4 v0 = acc[ai][bj][m][0] + bv[bj][0], v1 = acc[ai][bj][m][1] + bv[bj][1];
                    if (ACT == 1) { f32x2 a = gelu_pk((f32x2){v0[0], v0[1]}), b = gelu_pk((f32x2){v0[2], v0[3]}), c = gelu_pk((f32x2){v1[0], v1[1]}), d = gelu_pk((f32x2){v1[2], v1[3]});
                        v0 = (f32x4){a.x, a.y, b.x, b.y}; v1 = (f32x4){c.x, c.y, d.x, d.y}; }
                    v0 = v0 * sc; v1 = v1 * sc; u32x4 w; w.x = cvt_pk_bf16(v0[0], v0[1]); w.y = cvt_pk_bf16(v0[2], v0[3]); w.z = cvt_pk_bf16(v1[0], v1[1]); w.w = cvt_pk_bf16(v1[2], v1[3]);
                    *(u32x4*)(rowp + bj * HALF) = w; } }
    }
};
template <class Epi, class Sched, bool ALIGN_EPI = false, bool SP2 = false>
__device__ __forceinline__ void gemm_phase(PG8_LAS unsigned char* lds, const Gemm g, const Sched& S, const Epi& E) {
    const int tid = threadIdx.x, wid = __builtin_amdgcn_readfirstlane(tid >> 6), lane = tid & 63, wr = wid >> 2, wc = wid & 3, fr = lane & 15, fq = lane >> 4;
    const int K = g.K, nt = K / BK;
    unsigned voffA[2], voffB[2];
#pragma unroll
    for (int i = 0; i < 2; ++i) { int R, C; stage_rc(tid * 16 + i * 8192, R, C); const int Rb = Epi::PERM ? ((R & ~31) + perm32(R & 31)) : R;
        voffA[i] = (unsigned)(R * K + C) * 2u; voffB[i] = (unsigned)(Rb * K + C) * 2u; }
    const size_t kstep = (size_t)(BK * 2);
    const size_t hstep = (size_t)HALF * K * 2;
    const size_t tstep = 2 * hstep;
    const unsigned ldsw = (unsigned)wid * 1024u;
    const int aoff = lds_byte(wr * 64 + fr, fq * 8), boff = lds_byte(wc * 32 + fr, fq * 8);
#define PG8_SA(b, h) (((b) * 2 + (h)) * HTB)
#define PG8_SB(b, h) ((4 + (b) * 2 + (h)) * HTB)
#define PG8_STAGE(bufoff, gbase, voff) do { _Pragma("unroll") for (int _i = 0; _i < 2; ++_i) \
        __builtin_amdgcn_global_load_lds((const unsigned*)((const char*)(gbase) + (voff)[_i]), (PG8_LAS unsigned*)(lds + (bufoff) + ldsw + _i * 8192), 16, 0, 0); } while (0)
#define PG8_LDA(dst, b, h) do { _Pragma("unroll") for (int m = 0; m < 4; ++m) _Pragma("unroll") for (int k = 0; k < 2; ++k) dst[m][k] = *(const PG8_LAS bf16x8*)(lds + PG8_SA(b, h) + aoff + m * 2048 + k * 1024); } while (0)
#define PG8_LDB(dst, b, h) do { _Pragma("unroll") for (int n = 0; n < 2; ++n) _Pragma("unroll") for (int k = 0; k < 2; ++k) dst[n][k] = *(const PG8_LAS bf16x8*)(lds + PG8_SB(b, h) + boff + n * 2048 + k * 1024); } while (0)
#define PG8_MMA(ai, bj, At, Bt) do { __builtin_amdgcn_s_setprio(1); _Pragma("unroll") for (int m = 0; m < 4; ++m) _Pragma("unroll") for (int n = 0; n < 2; ++n) _Pragma("unroll") for (int k = 0; k < 2; ++k) \
        acc[ai][bj][m][n] = __builtin_amdgcn_mfma_f32_16x16x32_bf16(Bt[n][k], At[m][k], acc[ai][bj][m][n], 0, 0, 0); __builtin_amdgcn_s_setprio(0); } while (0)
#define PG8_WAIT_V(n) asm volatile("s_waitcnt vmcnt(" #n ")" ::: "memory")
#define PG8_WAIT_L(n) asm volatile("s_waitcnt lgkmcnt(" #n ")" ::: "memory")
#define PG8_BAR __builtin_amdgcn_s_barrier()
#define PG8_SCHED __builtin_amdgcn_sched_barrier(0)
    Unit cur, nxt; int ui = 0;
    if (!S.next(0, cur)) return;
    f32x4 acc[2][2][4][2];
#pragma unroll
    for (int a = 0; a < 2; ++a)
#pragma unroll
        for (int b = 0; b < 2; ++b)
#pragma unroll
            for (int m = 0; m < 4; ++m)
#pragma unroll
                for (int n = 0; n < 2; ++n) acc[a][b][m][n] = (f32x4){0.f, 0.f, 0.f, 0.f};
    bf16x8 At[4][2], B0[2][2], B1[2][2];
    const char* cA = (const char*)g.A + (size_t)cur.pm * tstep; const char* cB = (const char*)g.Bt + (size_t)cur.pn * tstep;
    S.a_ready(cur);
    if constexpr (SP2) {
        PG8_STAGE(PG8_SB(0, 0), cB, voffB); PG8_STAGE(PG8_SB(0, 1), cB + hstep, voffB); PG8_STAGE(PG8_SA(0, 0), cA, voffA); PG8_STAGE(PG8_SA(0, 1), cA + hstep, voffA);
        if (wr == 1) PG8_BAR;
        PG8_WAIT_V(2); PG8_BAR;
        PG8_STAGE(PG8_SB(1, 0), cB + kstep, voffB); PG8_STAGE(PG8_SA(1, 0), cA + kstep, voffA); PG8_STAGE(PG8_SB(1, 1), cB + hstep + kstep, voffB);
        PG8_WAIT_V(6); PG8_BAR;
    } else {
        PG8_STAGE(PG8_SB(0, 0), cB, voffB); PG8_STAGE(PG8_SA(0, 0), cA, voffA); PG8_STAGE(PG8_SB(0, 1), cB + hstep, voffB); PG8_STAGE(PG8_SA(0, 1), cA + hstep, voffA);
        if (wr == 1) PG8_BAR;
        PG8_WAIT_V(4); PG8_BAR;
        PG8_STAGE(PG8_SB(1, 0), cB + kstep, voffB); PG8_STAGE(PG8_SA(1, 0), cA + kstep, voffA); PG8_STAGE(PG8_SB(1, 1), cB + hstep + kstep, voffB);
        PG8_WAIT_V(6); PG8_BAR;
    }
    for (;;) {
        const bool has_next = S.next(ui + 1, nxt);
        const char* nA = has_next ? (const char*)g.A + (size_t)nxt.pm * tstep : cA; const char* nB = has_next ? (const char*)g.Bt + (size_t)nxt.pn * tstep : cB;
        for (int t = 0; t < nt; t += 2) {
            const bool last = (t == nt - 2);
            const char* a1 = cA + (size_t)(t + 1) * kstep;
            const char* a2 = last ? nA : cA + (size_t)(t + 2) * kstep; const char* b2 = last ? nB : cB + (size_t)(t + 2) * kstep;
            const char* a3 = a2 + kstep; const char* b3 = b2 + kstep;
            if (last && has_next) S.a_ready(nxt);
            if constexpr (SP2) {
            PG8_LDB(B0, 0, 0); PG8_LDB(B1, 0, 1); PG8_SCHED; PG8_LDA(At, 0, 0); PG8_STAGE(PG8_SA(1, 1), a1 + hstep, voffA);
            PG8_WAIT_V(8); PG8_WAIT_L(0); PG8_BAR; PG8_MMA(0, 0, At, B0); PG8_MMA(0, 1, At, B1); PG8_BAR; PG8_SCHED;
            PG8_LDA(At, 0, 1); PG8_STAGE(PG8_SB(0, 0), b2, voffB); PG8_STAGE(PG8_SB(0, 1), b2 + hstep, voffB); PG8_STAGE(PG8_SA(0, 0), a2, voffA);
            PG8_WAIT_V(8); PG8_WAIT_L(0); PG8_BAR; PG8_MMA(1, 0, At, B0); PG8_MMA(1, 1, At, B1); PG8_BAR; PG8_SCHED;
            PG8_LDB(B0, 1, 0); PG8_LDB(B1, 1, 1); PG8_SCHED; PG8_LDA(At, 1, 0); PG8_STAGE(PG8_SA(0, 1), a2 + hstep, voffA);
            PG8_WAIT_V(8); PG8_WAIT_L(0); PG8_BAR; PG8_MMA(0, 0, At, B0); PG8_MMA(0, 1, At, B1); PG8_BAR; PG8_SCHED;
            PG8_LDA(At, 1, 1); PG8_STAGE(PG8_SB(1, 0), b3, voffB); PG8_STAGE(PG8_SB(1, 1), b3 + hstep, voffB); PG8_STAGE(PG8_SA(1, 0), a3, voffA);
            PG8_WAIT_V(8); PG8_WAIT_L(0); PG8_BAR; PG8_MMA(1, 0, At, B0); PG8_MMA(1, 1, At, B1); PG8_BAR; PG8_SCHED;
            } else {
            PG8_LDB(B0, 0, 0); PG8_SCHED; PG8_LDA(At, 0, 0); PG8_STAGE(PG8_SA(1, 1), a1 + hstep, voffA);
            PG8_WAIT_L(8); PG8_BAR; PG8_WAIT_L(0); PG8_MMA(0, 0, At, B0); PG8_BAR; PG8_SCHED;
            PG8_LDB(B1, 0, 1); PG8_STAGE(PG8_SB(0, 0), b2, voffB);
            PG8_BAR; PG8_WAIT_L(0); PG8_MMA(0, 1, At, B1); PG8_BAR;
            PG8_LDA(At, 0, 1); PG8_STAGE(PG8_SA(0, 0), a2, voffA);
            PG8_BAR; PG8_WAIT_L(0); PG8_MMA(1, 0, At, B0); PG8_BAR; PG8_SCHED;
            PG8_STAGE(PG8_SB(0, 1), b2 + hstep, voffB);
            PG8_WAIT_V(6); PG8_BAR; PG8_MMA(1, 1, At, B1); PG8_BAR;
            PG8_LDB(B0, 1, 0); PG8_SCHED; PG8_LDA(At, 1, 0); PG8_STAGE(PG8_SA(0, 1), a2 + hstep, voffA);
            PG8_WAIT_L(8); PG8_BAR; PG8_WAIT_L(0); PG8_MMA(0, 0, At, B0); PG8_BAR; PG8_SCHED;
            PG8_LDB(B1, 1, 1); PG8_STAGE(PG8_SB(1, 0), b3, voffB);
            PG8_BAR; PG8_WAIT_L(0); PG8_MMA(0, 1, At, B1); PG8_BAR;
            PG8_LDA(At, 1, 1); PG8_STAGE(PG8_SA(1, 0), a3, voffA);
            PG8_BAR; PG8_WAIT_L(0); PG8_MMA(1, 0, At, B0); PG8_BAR; PG8_SCHED;
            PG8_STAGE(PG8_SB(1, 1), b3 + hstep, voffB);
            PG8_WAIT_V(6); PG8_BAR; PG8_MMA(1, 1, At, B1); PG8_BAR;
            }
        }
        if constexpr (ALIGN_EPI) { if (wr == 0) PG8_BAR; }
        if constexpr (!Epi::AFTER_DRAIN) { E(acc, cur, wr, wc, fr, fq); S.done(cur); }
        if (!has_next) break;
#pragma unroll
        for (int a = 0; a < 2; ++a)
#pragma unroll
            for (int b = 0; b < 2; ++b)
#pragma unroll
                for (int m = 0; m < 4; ++m)
#pragma unroll
                    for (int n = 0; n < 2; ++n) acc[a][b][m][n] = (f32x4){0.f, 0.f, 0.f, 0.f};
        cur = nxt; cA = nA; cB = nB; ++ui;
        if constexpr (ALIGN_EPI) { if (wr == 1) PG8_BAR; }
    }
    PG8_WAIT_V(0);
    if constexpr (!ALIGN_EPI) { if (wr == 0) PG8_BAR; }
    PG8_BAR;
    if constexpr (Epi::AFTER_DRAIN) { E.fused(acc, cur, wr, wc, fr, fq, lds, wid, lane); S.done(cur); }
#undef PG8_SA
#undef PG8_SB
#undef PG8_STAGE
#undef PG8_LDA
#undef PG8_LDB
#undef PG8_MMA
#undef PG8_WAIT_V
#undef PG8_WAIT_L
#undef PG8_BAR
#undef PG8_SCHED
}
}
#include <hip/hip_bf16.h>
#include <cmath>
namespace attn_body {
using bf16=__hip_bfloat16;
using bf16x8=__attribute__((ext_vector_type(8)))short;
using s16x4=__attribute__((ext_vector_type(4)))short;
using f32x16=__attribute__((ext_vector_type(16)))float;
using u32x4=__attribute__((ext_vector_type(4)))unsigned;
using f32x4=__attribute__((ext_vector_type(4)))float;
#define ALDS __attribute__((address_space(3)))
constexpr int BATCH=4,NHEAD=8,SEQ=8192,D=64,DM=1024;
constexpr int NW=8,QBLK=32,QB=QBLK*NW,KVBLK=64,NQB=SEQ/QB;
constexpr int ATTN_PITCH=DM, ATTN_UNIT_ROWS=QB;
__device__ __forceinline__ int crow(int r,int hi){return (r&3)+8*(r>>2)+4*hi;}
#define SBAR() __builtin_amdgcn_sched_barrier(0)
__device__ __forceinline__ void cmask(f32x16&p0,f32x16&p1,int jb,int qrel,int hi){
  const float NEG=-INFINITY; const int dq=qrel-64*jb-4*hi;
  #pragma unroll
  for(int r=0;r<16;++r){const int c=(r&3)+8*(r>>2); if(c>dq)p0[r]=NEG; if(c+32>dq)p1[r]=NEG;}
}

constexpr int NSLOT=3, SLOTB=8192;
constexpr int LDS_K=0, LDS_V=NSLOT*SLOTB, LDS_WS=2*NSLOT*SLOTB, LDS_OST=LDS_WS+NW*64*4, LDS_BIAS=LDS_OST+NW*4096, LDS_BYTES=LDS_BIAS+SEQ*4;
constexpr float C2=0.125f*1.4426950408889634f;
__device__ __forceinline__ void glds16(const void*gsrc,unsigned lds_dst){unsigned keep;
  asm volatile("s_mov_b32 %0, m0\n\ts_mov_b32 m0, %2\n\ts_nop 0\n\tglobal_load_lds_dwordx4 %1, off\n\ts_mov_b32 m0, %0":"=&s"(keep):"v"(gsrc),"s"(lds_dst):"memory");}
__device__ __forceinline__ float max3f(float a,float b,float c){float r;asm("v_max3_f32 %0, %1, %2, %3":"=v"(r):"v"(a),"v"(b),"v"(c));return r;}
__device__ __forceinline__ float max2f(float a,float b){float r;asm("v_max_f32_e32 %0, %1, %2":"=v"(r):"v"(a),"v"(b));return r;}
__device__ __forceinline__ float fadd_s(float a,float b){float r;asm("v_add_f32_e32 %0, %1, %2":"=v"(r):"v"(a),"v"(b));return r;}
__device__ __forceinline__ float fsub_s(float a,float b){float r;asm("v_sub_f32_e32 %0, %1, %2":"=v"(r):"v"(a),"v"(b));return r;}
typedef float f32x2_t __attribute__((ext_vector_type(2))); typedef __bf16 bf16x2_t __attribute__((ext_vector_type(2)));
__device__ __forceinline__ unsigned cvtpk_s(float lo,float hi){f32x2_t v={lo,hi};bf16x2_t b=__builtin_convertvector(v,bf16x2_t);return __builtin_bit_cast(unsigned,b);}
#define WAIT_BAR(N) asm volatile("s_waitcnt vmcnt(" #N ") lgkmcnt(0)\n\ts_barrier":::"memory")

__device__ __forceinline__ void qkt(f32x16&p0,f32x16&p1,const char*Kslot,const bf16x8*qr,const f32x16&c0,const f32x16&c1,int r32,int hi){
  const char*kb=Kslot+hi*1024+r32*16;
  #pragma unroll
  for(int d0=0;d0<4;++d0){
    const bf16x8 b0=*reinterpret_cast<const bf16x8*>(kb+d0*2048);
    const bf16x8 b1=*reinterpret_cast<const bf16x8*>(kb+d0*2048+512);
    if(d0==0){p0=__builtin_amdgcn_mfma_f32_32x32x16_bf16(b0,qr[0],c0,0,0,0);p1=__builtin_amdgcn_mfma_f32_32x32x16_bf16(b1,qr[0],c1,0,0,0);}
    else{p0=__builtin_amdgcn_mfma_f32_32x32x16_bf16(b0,qr[d0],p0,0,0,0);p1=__builtin_amdgcn_mfma_f32_32x32x16_bf16(b1,qr[d0],p1,0,0,0);}}
}
typedef __attribute__((address_space(3))) const char* lds_cptr;
typedef short v4i16_t __attribute__((ext_vector_type(4)));
__device__ __forceinline__ void kload8(bf16x8*kf,lds_cptr kp){
  kf[0]=*(const __attribute__((address_space(3))) bf16x8*)(kp);      kf[1]=*(const __attribute__((address_space(3))) bf16x8*)(kp+512);
  kf[2]=*(const __attribute__((address_space(3))) bf16x8*)(kp+2048); kf[3]=*(const __attribute__((address_space(3))) bf16x8*)(kp+2560);
  kf[4]=*(const __attribute__((address_space(3))) bf16x8*)(kp+4096); kf[5]=*(const __attribute__((address_space(3))) bf16x8*)(kp+4608);
  kf[6]=*(const __attribute__((address_space(3))) bf16x8*)(kp+6144); kf[7]=*(const __attribute__((address_space(3))) bf16x8*)(kp+6656);
}
__device__ __forceinline__ void kload2(bf16x8*kf,lds_cptr kp,int j){ kf[2*j]=*(const __attribute__((address_space(3))) bf16x8*)(kp+j*2048); kf[2*j+1]=*(const __attribute__((address_space(3))) bf16x8*)(kp+j*2048+512); }
__device__ __forceinline__ s16x4 vtr(lds_cptr p){ return __builtin_bit_cast(s16x4,__builtin_amdgcn_ds_read_tr16_b64_v4i16((__attribute__((address_space(3))) v4i16_t*)p)); }
__device__ __forceinline__ float rowmax(const f32x16&p0,const f32x16&p1){
  float a=max3f(p0[0],p0[1],p1[0]),b=max3f(p0[2],p0[3],p1[1]);a=max3f(a,p1[2],p1[3]);
  #pragma unroll
  for(int r=4;r<16;r+=4){a=max3f(a,p0[r],p0[r+1]);b=max3f(b,p0[r+2],p0[r+3]);a=max3f(a,p1[r],p1[r+1]);b=max3f(b,p1[r+2],p1[r+3]);}
  const float m=max2f(a,b);
  auto rr=__builtin_amdgcn_permlane32_swap(__float_as_uint(m),__float_as_uint(m),false,false);
  return max2f(__uint_as_float(rr[0]),__uint_as_float(rr[1]));
}
__device__ __forceinline__ void pv(f32x16*o,int vb,bf16x8 pa0,bf16x8 pa1,bf16x8 pa2,bf16x8 pa3){
  #pragma unroll
  for(int d0=0;d0<2;++d0){s16x4 lo[4],hi[4];
    #pragma unroll
    for(int ks=0;ks<4;++ks){
      asm volatile("ds_read_b64_tr_b16 %0,%1 offset:%c2":"=&v"(lo[ks]):"v"(vb),"i"(d0*4096+ks*1024):"memory");
      asm volatile("ds_read_b64_tr_b16 %0,%1 offset:%c2":"=&v"(hi[ks]):"v"(vb),"i"(d0*4096+ks*1024+512):"memory");}
    asm volatile("s_waitcnt lgkmcnt(0)":::"memory");SBAR();
    #define PK(k) (bf16x8){lo[k][0],lo[k][1],lo[k][2],lo[k][3],hi[k][0],hi[k][1],hi[k][2],hi[k][3]}
    o[d0]=__builtin_amdgcn_mfma_f32_32x32x16_bf16(pa0,PK(0),o[d0],0,0,0);
    o[d0]=__builtin_amdgcn_mfma_f32_32x32x16_bf16(pa1,PK(1),o[d0],0,0,0);
    o[d0]=__builtin_amdgcn_mfma_f32_32x32x16_bf16(pa2,PK(2),o[d0],0,0,0);
    o[d0]=__builtin_amdgcn_mfma_f32_32x32x16_bf16(pa3,PK(3),o[d0],0,0,0);
    #undef PK
  }
}

#ifndef ATTN_STORE16
#define ATTN_STORE16(p,v) (*(u32x4*)(p)=(v))
#endif
template<int THRL> __device__ __forceinline__ void attn_unit(int b,int h,int qb,const bf16*Q,const bf16*__restrict__ K,const bf16*__restrict__ V,bf16*O,const float*__restrict__ cfrow,float ub,char*shm){
  const int tid=threadIdx.x,lane=tid&63,r32=lane&31,hi=lane>>5; const int wid=__builtin_amdgcn_readfirstlane(tid>>6);
  const long rowbase=(long)b*SEQ; const int q0=qb*QB;
  const int NT0=(q0+QB)/KVBLK; int t0;
  { const float cref0=cfrow[q0], thr=-(2.f*ub+43.f); const int j0=lane,j1=lane+64;
    const bool p0=(j0<NT0-4)&&((cref0-cfrow[64*j0+63])*1.4426950408889634f<=thr);
    const bool p1=(j1<NT0-4)&&((cref0-cfrow[64*j1+63])*1.4426950408889634f<=thr);
    t0=(__popcll(__ballot(p0))+__popcll(__ballot(p1)))&~1; t0=__builtin_amdgcn_readfirstlane(t0); }
  const bf16*Qw=Q+(rowbase+q0+wid*QBLK)*DM+h*D;
  const bf16*Kh=K+(rowbase+(long)t0*KVBLK)*DM+h*D,*Vh=V+(rowbase+(long)t0*KVBLK)*DM+h*D;
  const unsigned lds0=(unsigned)(uintptr_t)shm;
  float*wsf=(float*)(shm+LDS_WS)+wid*64;
  const bf16*ksrc=Kh+(long)lane*DM+wid*8;
  const bf16*vsrc=Vh+(long)(16*(wid&3)+(lane>>2))*DM+(wid>>2)*32+(lane&3)*8;
  const unsigned kdst=lds0+LDS_K+wid*1024, vdst=lds0+LDS_V+wid*1024;
  #define DMA_K(t,slot) glds16(ksrc+(long)(t)*KVBLK*DM,(unsigned)__builtin_amdgcn_readfirstlane(kdst+(slot)))
  #define DMA_V(t,slot) glds16(vsrc+(long)(t)*KVBLK*DM,(unsigned)__builtin_amdgcn_readfirstlane(vdst+(slot)))
  const int vb0=(int)(lds0+LDS_V)+((lane>>4)&1)*32+(lane&3)*8+(4*hi+((lane&15)>>2))*64;
  const char*Kbase=shm+LDS_K; bf16x8 kf[8];
  const lds_cptr shm3=(lds_cptr)shm; const lds_cptr kp0=shm3+LDS_K+hi*1024+r32*16; const lds_cptr vp0=shm3+LDS_V+((lane>>4)&1)*32+(lane&3)*8+(4*hi+((lane&15)>>2))*64;
  const int NT=NT0-t0;
  { const float cref=cfrow[q0]; ALDS float*bw=(ALDS float*)(shm3+LDS_BIAS);
    _Pragma("clang loop unroll(disable) vectorize(disable)")
    for(int i=tid;i<NT*KVBLK;i+=NW*64) bw[i]=(cref-cfrow[t0*KVBLK+i])*1.4426950408889634f; }
  const ALDS float*bl=(const ALDS float*)(shm3+LDS_BIAS)+4*hi;
  #define LDBIAS(X0,X1,t) do{ const ALDS float*bp_=bl+(t)*KVBLK; \
    _Pragma("unroll") for(int g_=0;g_<4;++g_){ const f32x4 a_=*(const ALDS f32x4*)(bp_+8*g_); const f32x4 b_=*(const ALDS f32x4*)(bp_+32+8*g_); \
      X0[4*g_]=a_[0];X0[4*g_+1]=a_[1];X0[4*g_+2]=a_[2];X0[4*g_+3]=a_[3]; X1[4*g_]=b_[0];X1[4*g_+1]=b_[1];X1[4*g_+2]=b_[2];X1[4*g_+3]=b_[3]; } }while(0)
  DMA_K(0,0);DMA_V(0,0);DMA_K(1,SLOTB);
  bf16x8 qr[4];
  #pragma unroll
  for(int d0=0;d0<4;++d0)qr[d0]=*reinterpret_cast<const bf16x8*>(&Qw[(long)r32*DM+d0*16+hi*8]);
  float mhat=0.f,l_reg=0.f;f32x16 o[2];o[0]=f32x16{};o[1]=f32x16{};
  const int qrel=wid*QBLK+r32;
  #define CMASK(P0,P1,t) do{int jb_=(t)-(NT-4); if(jb_>=0)cmask(P0,P1,jb_,qrel,hi);}while(0)
  bool resc=false;
  #define START(P0,P1) do{ const float rm=rowmax(P0,P1); resc=false; \
    { const float dl=rm; mhat=fadd_s(mhat,dl); \
      _Pragma("unroll") for(int r=0;r<16;++r){P0[r]=fsub_s(P0[r],dl);P1[r]=fsub_s(P1[r],dl);} \
      } \
    _Pragma("unroll") for(int r=0;r<16;++r)P0[r]=__builtin_amdgcn_exp2f(P0[r]); }while(0)
  #define RESC() do{ if(resc){ asm volatile("s_waitcnt lgkmcnt(0)":::"memory"); \
      _Pragma("unroll") for(int d_=0;d_<2;++d_) _Pragma("unroll") for(int r=0;r<16;++r)o[d_][r]*=wsf[crow(r,hi)]; } }while(0)
  f32x16 pA0,pA1,pB0,pB1;
  int sl_prev=0,sl_cur=0,sl_next=SLOTB;
  #define ROT() do{sl_prev=sl_cur;sl_cur=sl_next;sl_next=(sl_next==(NSLOT-1)*SLOTB)?0:sl_next+SLOTB;}while(0)
  DMA_K(2,2*SLOTB);
  WAIT_BAR(3);
  LDBIAS(pB0,pB1,0); qkt(pA0,pA1,Kbase,qr,pB0,pB1,r32,hi);asm volatile("s_nop 15\n\ts_nop 7":"+v"(pA0),"+v"(pA1));CMASK(pA0,pA1,0);
  START(pA0,pA1);
  _Pragma("unroll") for(int r=0;r<16;++r)pA1[r]=__builtin_amdgcn_exp2f(pA1[r]);
  WAIT_BAR(0);
  DMA_K(3,0);DMA_V(1,SLOTB);
  ROT();
  kload8(kf,kp0+sl_cur);
  WAIT_BAR(2);
  s16x4 vlo[8],vhi[8]; u32x4 pw0,pw1,pw2,pw3;
  #define PKW(P,B) cvtpk_s(P[B],P[B+1])
  #define PAF(k) __builtin_bit_cast(bf16x8,pw##k)
  #define VFR(i) (bf16x8){vlo[i][0],vlo[i][1],vlo[i][2],vlo[i][3],vhi[i][0],vhi[i][1],vhi[i][2],vhi[i][3]}
  #define PIN(x) asm volatile("":"+v"(x))
  #define MX3(a,b,c) __builtin_fmaxf(__builtin_fmaxf((a),(b)),(c))
  #define GAPA(MF,A0,A1,A2,A3,W0,W1,PW) do{ MF; sacc+=A0; sacc+=A1; sacc+=A2; sacc+=A3; PIN(sacc); W0; W1; PIN(PW); SBAR(); }while(0)
  #define EX(v) __builtin_amdgcn_exp2f(v)
  #define GAPB(MF,X,B) do{ MF; X[B]=EX(X[B]); X[B+1]=EX(X[B+1]); X[B+2]=EX(X[B+2]); X[B+3]=EX(X[B+3]); PIN(X); SBAR(); }while(0)
  #define VRD(i) do{ vlo[i]=vtr(vp_+(((i)>>2)*4096+((i)&3)*1024)); vhi[i]=vtr(vp_+(((i)>>2)*4096+((i)&3)*1024+512)); }while(0)
  #define KRD(G,j) do{ if(G){ kload2(kf,kp0+sl_next,j); SBAR(); } }while(0)
  #define STEP(C0,C1,P0,P1,t,GK,GV,GL) do{ SBAR(); \
    _Pragma("unroll") for(int r=0;r<16;++r){C0[r]-=mhat;C1[r]-=mhat;} \
    const lds_cptr vp_=vp0+sl_prev; \
    VRD(0); SBAR(); float sacc=(P0[0]+P0[1]); \
    GAPA(C0=__builtin_amdgcn_mfma_f32_32x32x16_bf16(kf[0],qr[0],C0,0,0,0), P0[2],P0[3],P0[4],P0[5],     pw0[0]=PKW(P0,0), pw0[1]=PKW(P0,2), pw0); \
    VRD(4); SBAR(); GAPA(C1=__builtin_amdgcn_mfma_f32_32x32x16_bf16(kf[1],qr[0],C1,0,0,0), P0[6],P0[7],P0[8],P0[9],     pw0[2]=PKW(P0,4), pw0[3]=PKW(P0,6), pw0); \
    VRD(1); SBAR(); GAPA(C0=__builtin_amdgcn_mfma_f32_32x32x16_bf16(kf[2],qr[1],C0,0,0,0),   P0[10],P0[11],P0[12],P0[13], pw1[0]=PKW(P0,8), pw1[1]=PKW(P0,10), pw1); \
    VRD(5); SBAR(); GAPA(C1=__builtin_amdgcn_mfma_f32_32x32x16_bf16(kf[3],qr[1],C1,0,0,0),   P0[14],P0[15],P1[0],P1[1],   pw1[2]=PKW(P0,12),pw1[3]=PKW(P0,14), pw1); \
    VRD(2); SBAR(); GAPA(C0=__builtin_amdgcn_mfma_f32_32x32x16_bf16(kf[4],qr[2],C0,0,0,0),   P1[2],P1[3],P1[4],P1[5],     pw2[0]=PKW(P1,0), pw2[1]=PKW(P1,2), pw2); \
    VRD(6); SBAR(); GAPA(C1=__builtin_amdgcn_mfma_f32_32x32x16_bf16(kf[5],qr[2],C1,0,0,0),   P1[6],P1[7],P1[8],P1[9],     pw2[2]=PKW(P1,4), pw2[3]=PKW(P1,6), pw2); \
    VRD(3); SBAR(); GAPA(C0=__builtin_amdgcn_mfma_f32_32x32x16_bf16(kf[6],qr[3],C0,0,0,0),   P1[10],P1[11],P1[12],P1[13], pw3[0]=PKW(P1,8), pw3[1]=PKW(P1,10), pw3); \
    VRD(7); SBAR(); GAPA(C1=__builtin_amdgcn_mfma_f32_32x32x16_bf16(kf[7],qr[3],C1,0,0,0),   P1[14],P1[15],0.f,0.f,       pw3[2]=PKW(P1,12),pw3[3]=PKW(P1,14), pw3); \
    l_reg+=sacc; \
    if(GK){DMA_K((t)+3,sl_cur);} if(GV){DMA_V((t)+1,sl_next);} \
    CMASK(C0,C1,t); \
    { float a=MX3(C0[0],C0[1],C1[0]),b=MX3(C0[2],C0[3],C1[1]); a=MX3(a,C1[2],C1[3]); \
      _Pragma("unroll") for(int r=4;r<16;r+=4){a=MX3(a,C0[r],C0[r+1]);b=MX3(b,C0[r+2],C0[r+3]);a=MX3(a,C1[r],C1[r+1]);b=MX3(b,C1[r+2],C1[r+3]);} \
      float rm=__builtin_fmaxf(a,b); { auto rr=__builtin_amdgcn_permlane32_swap(__float_as_uint(rm),__float_as_uint(rm),false,false); rm=__builtin_fmaxf(__uint_as_float(rr[0]),__uint_as_float(rr[1])); } \
      resc=false; \
      if(__builtin_expect(__any(rm>(float)THRL),0)){ const float dl=__builtin_fmaxf(rm,0.f); mhat+=dl; \
        _Pragma("unroll") for(int r=0;r<16;++r){C0[r]-=dl;C1[r]-=dl;} \
        const float f=__builtin_amdgcn_exp2f(-dl); l_reg*=f; if(hi==0)wsf[r32]=f; resc=true; } } \
    SBAR(); \
    GAPB(o[0]=__builtin_amdgcn_mfma_f32_32x32x16_bf16(PAF(0),VFR(0),o[0],0,0,0), C0,0); \
    GAPB(o[1]=__builtin_amdgcn_mfma_f32_32x32x16_bf16(PAF(0),VFR(4),o[1],0,0,0), C0,4); \
    KRD(GL,0); GAPB(o[0]=__builtin_amdgcn_mfma_f32_32x32x16_bf16(PAF(1),VFR(1),o[0],0,0,0), C0,8); \
    KRD(GL,1); GAPB(o[1]=__builtin_amdgcn_mfma_f32_32x32x16_bf16(PAF(1),VFR(5),o[1],0,0,0), C0,12); \
    KRD(GL,2); GAPB(o[0]=__builtin_amdgcn_mfma_f32_32x32x16_bf16(PAF(2),VFR(2),o[0],0,0,0), C1,0); \
    KRD(GL,3); GAPB(o[1]=__builtin_amdgcn_mfma_f32_32x32x16_bf16(PAF(2),VFR(6),o[1],0,0,0), C1,4); \
    GAPB(o[0]=__builtin_amdgcn_mfma_f32_32x32x16_bf16(PAF(3),VFR(3),o[0],0,0,0), C1,8); \
    GAPB(o[1]=__builtin_amdgcn_mfma_f32_32x32x16_bf16(PAF(3),VFR(7),o[1],0,0,0), C1,12); \
    if(GL){LDBIAS(P0,P1,(t)+1);} \
    }while(0)
  LDBIAS(pB0,pB1,1);
  int t=1;
  #undef CMASK
  #define CMASK(P0,P1,t) do{}while(0)
  for(;t+5<NT;t+=2){
    STEP(pB0,pB1,pA0,pA1,t,true,true,true);     WAIT_BAR(2); RESC(); ROT();
    STEP(pA0,pA1,pB0,pB1,t+1,true,true,true);   WAIT_BAR(2); RESC(); ROT();
  }
  #undef CMASK
  #define CMASK(P0,P1,t) do{int jb_=(t)-(NT-4); if(jb_>=0)cmask(P0,P1,jb_,qrel,hi);}while(0)
  #define ENDW(tt) do{ if((tt)+3<NT){WAIT_BAR(2);} else if((tt)+2<NT){WAIT_BAR(1);} else {WAIT_BAR(0);} }while(0)
  for(;t+1<NT;t+=2){
    STEP(pB0,pB1,pA0,pA1,t,(t+3<NT),(t+1<NT),(t+1<NT));       ENDW(t);   RESC(); ROT();
    STEP(pA0,pA1,pB0,pB1,t+1,(t+4<NT),(t+2<NT),(t+2<NT));     ENDW(t+1); RESC(); ROT();
  }
  STEP(pB0,pB1,pA0,pA1,NT-1,false,false,false); RESC();
  { float sacc=pB0[0]+pB0[1]; _Pragma("unroll") for(int r=2;r<16;++r)sacc+=pB0[r]; _Pragma("unroll") for(int r=0;r<16;++r)sacc+=pB1[r]; l_reg+=sacc;
    pw0=(u32x4){PKW(pB0,0),PKW(pB0,2),PKW(pB0,4),PKW(pB0,6)};pw1=(u32x4){PKW(pB0,8),PKW(pB0,10),PKW(pB0,12),PKW(pB0,14)};pw2=(u32x4){PKW(pB1,0),PKW(pB1,2),PKW(pB1,4),PKW(pB1,6)};pw3=(u32x4){PKW(pB1,8),PKW(pB1,10),PKW(pB1,12),PKW(pB1,14)};
    SBAR(); pv(o,vb0+sl_cur,PAF(0),PAF(1),PAF(2),PAF(3)); }
  #undef PKW
  #undef PAF
  #undef VFR
  #undef PIN
  #undef MX3
  #undef GAPA
  #undef GAPB
  #undef EX
  #undef VRD
  #undef KRD
  #undef STEP
  #undef ENDW
  {auto rr=__builtin_amdgcn_permlane32_swap(__float_as_uint(l_reg),__float_as_uint(l_reg),false,false);l_reg=__uint_as_float(rr[0])+__uint_as_float(rr[1]);}
  if(hi==0)wsf[32+r32]=l_reg;asm volatile("s_waitcnt lgkmcnt(0)":::"memory");
  float rli[16];
  #pragma unroll
  for(int r=0;r<16;++r)rli[r]=__builtin_amdgcn_rcpf(wsf[32+crow(r,hi)]);
  bf16*Ow=O+(rowbase+q0+wid*QBLK)*DM+h*D;
  { bf16*stg=(bf16*)(shm+LDS_OST)+wid*2048;
    #pragma unroll
    for(int r=0;r<16;++r){const int orow=crow(r,hi);
      #pragma unroll
      for(int d0=0;d0<2;++d0)stg[orow*64+d0*32+r32]=__float2bfloat16(o[d0][r]*rli[r]);}
    asm volatile("s_waitcnt lgkmcnt(0)":::"memory");
    #pragma unroll
    for(int i=0;i<4;++i){const int row=i*8+(lane>>3),ch=lane&7; const u32x4 v=*(const u32x4*)(stg+row*64+ch*8); ATTN_STORE16(Ow+(long)row*DM+ch*8,v);} }
  asm volatile("s_waitcnt lgkmcnt(0)\n\ts_barrier":::"memory");
  #undef LDBIAS
  #undef DMA_K
  #undef DMA_V
  #undef CMASK
  #undef START
  #undef RESC
  #undef ROT
}
constexpr int ATTN_LDS_BYTES=LDS_BYTES;
struct AttnTensors { const bf16* Q; const bf16* K; const bf16* V; bf16* O; const float* CF; const float* UB; };
struct AttnUnit { int bh; int qb; };
struct StaticOrder {
  int vcu;
  __device__ __forceinline__ explicit StaticOrder(int grid,int block):vcu((block%8)*(grid/8)+block/8){}
  __device__ __forceinline__ bool next(int i,AttnUnit&u)const{ if(i>=4)return false; const int s=vcu&7; u.bh=vcu>>3; u.qb=(i==0)?s:(i==1)?15-s:(i==2)?16+s:31-s; return true; }
  __device__ __forceinline__ void a_ready(const AttnUnit&)const{}
  __device__ __forceinline__ void done(const AttnUnit&)const{}
};
template<class Sched,int THRL=8> __device__ __forceinline__ void attn_phase(char*lds,const AttnTensors&T,const Sched&S){
  AttnUnit u;
  for(int i=0;S.next(i,u);++i){ S.a_ready(u); attn_unit<THRL>(u.bh/NHEAD,u.bh%NHEAD,u.qb,T.Q,T.K,T.V,T.O,T.CF+(long)u.bh*SEQ,sqrtf(T.UB[u.bh]*T.UB[32+u.bh])*1.01f,lds); S.done(u); }
}
#undef SBAR
#undef WAIT_BAR
}

namespace pg8 {
__device__ __forceinline__ float silu_f(float x) { return x * __builtin_amdgcn_rcpf(1.0f + __builtin_amdgcn_exp2f(-1.4426950408889634f * x)); }
struct EpiSwiGLU {
    static constexpr bool PERM = true, AFTER_DRAIN = false;
    bf16_t* O; int ldc; const float* rs;
    __device__ __forceinline__ void operator()(const f32x4 (&acc)[2][2][4][2], const Unit& u, int wr, int wc, int fr, int fq) const {
        const int row0 = u.pm * BM + wr * 64 + fr, col0 = u.pn * HALF + wc * 32 + 8 * fq;
#pragma unroll
        for (int ai = 0; ai < 2; ++ai)
#pragma unroll
            for (int m = 0; m < 4; ++m) { const int row = row0 + ai * HALF + m * 16; const float r = rs[row];
                const f32x4 g0 = acc[ai][0][m][0] * r, g1 = acc[ai][0][m][1] * r, u0 = acc[ai][1][m][0] * r, u1 = acc[ai][1][m][1] * r;
                u32x4 w; w.x = cvt_pk_bf16(silu_f(g0[0]) * u0[0], silu_f(g0[1]) * u0[1]); w.y = cvt_pk_bf16(silu_f(g0[2]) * u0[2], silu_f(g0[3]) * u0[3]);
                w.z = cvt_pk_bf16(silu_f(g1[0]) * u1[0], silu_f(g1[1]) * u1[1]); w.w = cvt_pk_bf16(silu_f(g1[2]) * u1[2], silu_f(g1[3]) * u1[3]);
                __builtin_nontemporal_store(w, (u32x4*)(O + (size_t)row * ldc + col0)); }
    }
};
struct EpiRowSS {
    static constexpr bool PERM = true, AFTER_DRAIN = false;
    bf16_t* O; int ldc; float* ss;
    __device__ __forceinline__ void operator()(const f32x4 (&acc)[2][2][4][2], const Unit& u, int wr, int wc, int fr, int fq) const {
        const int row0 = u.pm * BM + wr * 64 + fr, col0 = u.pn * BM + wc * 32 + 8 * fq;
#pragma unroll
        for (int ai = 0; ai < 2; ++ai)
#pragma unroll
            for (int m = 0; m < 4; ++m) { const int row = row0 + ai * HALF + m * 16; float s = 0.f;
#pragma unroll
                for (int bj = 0; bj < 2; ++bj) { const f32x4 v0 = acc[ai][bj][m][0], v1 = acc[ai][bj][m][1];
                    s += (v0[0] * v0[0] + v0[1] * v0[1]) + (v0[2] * v0[2] + v0[3] * v0[3]) + (v1[0] * v1[0] + v1[1] * v1[1]) + (v1[2] * v1[2] + v1[3] * v1[3]);
                    u32x4 w; w.x = cvt_pk_bf16(v0[0], v0[1]); w.y = cvt_pk_bf16(v0[2], v0[3]); w.z = cvt_pk_bf16(v1[0], v1[1]); w.w = cvt_pk_bf16(v1[2], v1[3]);
                    __builtin_nontemporal_store(w, (u32x4*)(O + (size_t)row * ldc + col0 + bj * HALF)); }
                s += __shfl_xor(s, 16); s += __shfl_xor(s, 32);
                if (fq == 0) ss[(size_t)row * 16 + u.pn * 4 + wc] = s; }
    }
};
struct EpiScale {
    static constexpr bool PERM = true, AFTER_DRAIN = false;
    bf16_t* O; int ldc; const float* rs; float scale;
    __device__ __forceinline__ void operator()(const f32x4 (&acc)[2][2][4][2], const Unit& u, int wr, int wc, int fr, int fq) const {
        const int row0 = u.pm * BM + wr * 64 + fr, col0 = u.pn * BM + wc * 32 + 8 * fq;
#pragma unroll
        for (int ai = 0; ai < 2; ++ai)
#pragma unroll
            for (int m = 0; m < 4; ++m) { const int row = row0 + ai * HALF + m * 16; const float r = rs ? rs[row] * scale : scale;
#pragma unroll
                for (int bj = 0; bj < 2; ++bj) { const f32x4 v0 = acc[ai][bj][m][0] * r, v1 = acc[ai][bj][m][1] * r;
                    u32x4 w; w.x = cvt_pk_bf16(v0[0], v0[1]); w.y = cvt_pk_bf16(v0[2], v0[3]); w.z = cvt_pk_bf16(v1[0], v1[1]); w.w = cvt_pk_bf16(v1[2], v1[3]);
                    *(u32x4*)(O + (size_t)row * ldc + col0 + bj * HALF) = w; } }
    }
};
struct EpiInProj {
    static constexpr bool PERM = true, AFTER_DRAIN = false;
    bf16_t *MIX, *KV, *GQK, *GR; float* SMALL; float* FZT; const float* rs; float qscale;
    __device__ __forceinline__ void operator()(const f32x4 (&acc)[2][2][4][2], const Unit& u, int wr, int wc, int fr, int fq) const {
        const int row0 = u.pm * BM + wr * 64 + fr, pn = u.pn;
        if (pn == 12) {
            if (wc == 0 && fq < 3) {
#pragma unroll
                for (int ai = 0; ai < 2; ++ai)
#pragma unroll
                    for (int m = 0; m < 4; ++m) { const int row = row0 + ai * HALF + m * 16; const float r = rs[row];
                        const f32x4 v0 = acc[ai][0][m][0] * r, v1 = acc[ai][0][m][1] * r;
                        if (fq == 0) {
#pragma unroll
                            for (int c = 0; c < 4; ++c) { FZT[(size_t)c * 32768 + row] = v0[c]; FZT[(size_t)(c + 4) * 32768 + row] = v1[c]; } }
                        else { *(f32x4*)(SMALL + (size_t)row * 16 + 8 * (fq - 1)) = v0; *(f32x4*)(SMALL + (size_t)row * 16 + 8 * (fq - 1) + 4) = v1; } }
            }
            return;
        }
        bf16_t* base; int ldc, c0; float sc = 1.f;
        if (pn < 2) { base = MIX; ldc = 1024; c0 = pn * 256; sc = qscale; }
        else if (pn < 4) { base = KV; ldc = 1024; c0 = (pn - 2) * 256; }
        else if (pn < 6) { base = KV; ldc = 1024; c0 = 512 + (pn - 4) * 256; }
        else if (pn < 8) { base = GQK; ldc = 512; c0 = (pn - 6) * 256; }
        else if (pn < 10) { base = MIX; ldc = 1024; c0 = 512 + (pn - 8) * 256; }
        else { base = GR; ldc = 512; c0 = (pn - 10) * 256; }
        const int col0 = c0 + wc * 32 + 8 * fq;
#pragma unroll
        for (int ai = 0; ai < 2; ++ai)
#pragma unroll
            for (int m = 0; m < 4; ++m) { const int row = row0 + ai * HALF + m * 16; const float r = rs[row] * sc;
#pragma unroll
                for (int bj = 0; bj < 2; ++bj) { const f32x4 v0 = acc[ai][bj][m][0] * r, v1 = acc[ai][bj][m][1] * r;
                    u32x4 w; w.x = cvt_pk_bf16(v0[0], v0[1]); w.y = cvt_pk_bf16(v0[2], v0[3]); w.z = cvt_pk_bf16(v1[0], v1[1]); w.w = cvt_pk_bf16(v1[2], v1[3]);
                    *(u32x4*)(base + (size_t)row * ldc + col0 + bj * HALF) = w; } }
    }
};
struct OneUnit { int pm, pn; bool has;
    __device__ bool next(int i, Unit& u) const { if (i != 0 || !has) return false; u.pm = pm; u.pn = pn; return true; }
    __device__ __forceinline__ void a_ready(const Unit&) const {}
    __device__ __forceinline__ void done(const Unit&) const {} };
}

namespace cg = cooperative_groups;
#define LAS __attribute__((address_space(3)))
typedef unsigned short bf16;
typedef unsigned v4u __attribute__((ext_vector_type(4)));
typedef unsigned v2u __attribute__((ext_vector_type(2)));
typedef float f32x4 __attribute__((ext_vector_type(4)));
typedef short bf16x8 __attribute__((ext_vector_type(8)));

typedef __attribute__((address_space(1))) unsigned gu32;
#define XB_TMO      128
#define XB_XCNT(j)  (256  + 64 * (j))
#define XB_XSUB(j)  (1280 + 64 * (j))
#define XB_XGEN(j)  (2304 + 64 * (j))
#define XB_TOP      3328
#define XB_TOPGEN   3392
#define XCD_BAR_WORDS 3456
#define XB_SPIN_CAP (1u << 18)

__device__ __forceinline__ unsigned xb_ld(unsigned* p)              { return __hip_atomic_load(p, __ATOMIC_RELAXED, __HIP_MEMORY_SCOPE_AGENT); }
__device__ __forceinline__ unsigned xb_add(unsigned* p, unsigned v) { return __hip_atomic_fetch_add(p, v, __ATOMIC_RELAXED, __HIP_MEMORY_SCOPE_AGENT); }
__device__ __forceinline__ unsigned xb_xcc_id() { return (unsigned)__builtin_amdgcn_s_getreg((3 << 11) | 20) & 0xFu; }
#define XB_SPIN(cond, bar) do { unsigned _sp = 0; while (cond) { __builtin_amdgcn_s_sleep(1); \
    if ((++_sp & 255u) == 0u) { if (xb_ld(&(bar)[XB_TMO])) break; if (_sp > XB_SPIN_CAP) { atomicAdd(&(bar)[XB_TMO], 1u); break; } } } } while (0)

struct XcdBarrier {
    unsigned* bar; unsigned x;
    volatile LAS unsigned* st;
};

__device__ __forceinline__ XcdBarrier xcd_barrier_post(unsigned* bar, volatile LAS unsigned* st) {
    XcdBarrier b; b.bar = bar; b.x = xb_xcc_id(); b.st = st;
    if (threadIdx.x == 0) (void)xb_add(&bar[XB_XCNT(b.x)], 1u);
    return b;
}
__device__ __forceinline__ void xcd_barrier_complete(unsigned* bar, unsigned x, unsigned& nloc, unsigned& nx) {
    const unsigned G = gridDim.x * gridDim.y * gridDim.z;
    unsigned sum, cnt, mine, sp = 0u;
    for (;;) {
        sum = 0u; cnt = 0u; mine = 0u;
#pragma unroll
        for (unsigned j = 0; j < 16; ++j) { const unsigned c = xb_ld(&bar[XB_XCNT(j)]); sum += c; cnt += (c > 0u) ? 1u : 0u; mine = (j == x) ? c : mine; }
        if (sum == G) break;
        __builtin_amdgcn_s_sleep(1);
        if ((++sp & 255u) == 0u) { if (xb_ld(&bar[XB_TMO])) break; if (sp > XB_SPIN_CAP) { atomicAdd(&bar[XB_TMO], 1u); break; } }
    }
    nloc = mine > 0u ? mine : 1u; nx = cnt > 0u ? cnt : 1u;
}

__device__ __forceinline__ void xcd_barrier(const XcdBarrier& b) {
    asm volatile("s_waitcnt vmcnt(0)" ::: "memory");
    __syncthreads();
    if (threadIdx.x == 0) {
        unsigned* bar = b.bar;
        __builtin_amdgcn_s_waitcnt(0);
        unsigned nloc = b.st[0], nx = b.st[1];
        if (nloc == 0u) { xcd_barrier_complete(bar, b.x, nloc, nx); b.st[0] = nloc; b.st[1] = nx; }
        const unsigned old = xb_add(&bar[XB_XSUB(b.x)], 1u);
        const unsigned gen = old / nloc;
        if (old + 1u == (gen + 1u) * nloc) {
            __builtin_amdgcn_fence(__ATOMIC_RELEASE, "agent");
            asm volatile("s_waitcnt vmcnt(0)" ::: "memory");
            const unsigned og = xb_add(&bar[XB_TOP], 1u);
            const unsigned tg = og / nx;
            if (og + 1u == (tg + 1u) * nx) xb_add(&bar[XB_TOPGEN], 1u);
            else XB_SPIN(xb_ld(&bar[XB_TOPGEN]) == tg, bar);
            __builtin_amdgcn_fence(__ATOMIC_ACQUIRE, "agent");
            xb_add(&bar[XB_XGEN(b.x)], 1u);
            asm volatile("s_waitcnt vmcnt(0)" ::: "memory");
        } else {
            XB_SPIN(xb_ld(&bar[XB_XGEN(b.x)]) == gen, bar);
            __builtin_amdgcn_fence(__ATOMIC_ACQUIRE, "agent");
            asm volatile("s_waitcnt vmcnt(0)" ::: "memory");
        }
    }
    __syncthreads();
}

constexpr int NWAVES = 8, NTHR = 512;
constexpr int T = 32768, DM = 1024, SEQ = 8192, NB = 4, FF = 2816, NGU = 5632, NIN = 3328;
constexpr float EPS = 1e-6f, LOG2E = 1.4426950408889634f;
constexpr size_t MiB = 1u << 20;
constexpr size_t WS_CTL = 0, CTL_ZERO_BYTES = 65536;
constexpr int MISC_OFF = 147456 - 128;
constexpr size_t WS_WGU1 = 2 * MiB, WS_WD1 = 14 * MiB, WS_WIN = 20 * MiB, WS_WOUT = 27 * MiB, WS_WMQ = 29 * MiB, WS_WMKV = 31 * MiB, WS_WMO = 35 * MiB,
                 WS_WGU2 = 37 * MiB, WS_WD2 = 48 * MiB, WS_MEMN = 54 * MiB, WS_KM = 56 * MiB, WS_VT = 58 * MiB, WS_RSTD = 60 * MiB, WS_ROWSS = 61 * MiB,
                 WS_SMALL = 63 * MiB, WS_CF = 67 * MiB, WS_DEC = 68 * MiB, WS_UB = 69 * MiB, WS_XB = 70 * MiB, WS_FB = 134 * MiB, WS_GR = 198 * MiB, WS_SCH = 230 * MiB,
                 WS_ACT = 294 * MiB, WS_MIX = 294 * MiB, WS_KV = 358 * MiB, WS_GQK = 422 * MiB, WS_QM = 294 * MiB, WS_OM = 358 * MiB, WS_BCG = 470 * MiB, WS_END = 502 * MiB;
constexpr int LDS_BYTES = 147456;
constexpr int NPH = 17;

typedef float f32x2_ __attribute__((ext_vector_type(2))); typedef __bf16 bf16x2_ __attribute__((ext_vector_type(2)));
__device__ __forceinline__ unsigned pk2(float lo, float hi) { f32x2_ v = {lo, hi}; return __builtin_bit_cast(unsigned, __builtin_convertvector(v, bf16x2_)); }
__device__ __forceinline__ unsigned f2bf(float f) { return pk2(f, 0.f) & 0xffffu; }
__device__ __forceinline__ float bf2f(unsigned b) { return __builtin_bit_cast(float, b << 16); }
__device__ __forceinline__ float bflo(unsigned w) { return __builtin_bit_cast(float, w << 16); }
__device__ __forceinline__ float bfhi(unsigned w) { return __builtin_bit_cast(float, w & 0xffff0000u); }
__device__ __forceinline__ float wave_sum(float v) {
#pragma unroll
    for (int o = 1; o < 64; o <<= 1) v += __shfl_xor(v, o);
    return v;
}
__device__ __forceinline__ float logsig(float x) { return fminf(x, 0.f) - __logf(1.0f + __expf(-fabsf(x))); }
__device__ __forceinline__ float silu1(float x) { return x * __builtin_amdgcn_rcpf(1.0f + __builtin_amdgcn_exp2f(-LOG2E * x)); }

template <int MAP> __device__ __forceinline__ int src_col(int R) {
    if (MAP == 0) return R;
    if (MAP == 1) { const int pn = R >> 8, w = R & 255; return (w < 128) ? pn * 128 + w : FF + pn * 128 + (w - 128); }
    if (R < 1536) return R;
    if (R < 3072) return R + 8;
    if (R < 3080) return R - 1536;
    if (R < 3096) return R;
    return -1;
}
template <int MAP> __device__ __forceinline__ void transpose_item(const float* __restrict__ W, int ldn, int K, bf16* WT, const float* __restrict__ g, LAS float* scr, int item, int nblk, int lane) {
    const int kb = item / nblk, nb = item % nblk, k0 = 64 * kb, n0 = 64 * nb;
    const int cg = (lane & 15) * 4, sc = src_col<MAP>(n0 + cg);
    f32x4 v[16];
#pragma unroll
    for (int i = 0; i < 16; ++i) { const int kk = 4 * i + (lane >> 4); v[i] = (f32x4){0.f, 0.f, 0.f, 0.f}; if (sc >= 0) v[i] = __builtin_nontemporal_load((const f32x4*)(W + (size_t)(k0 + kk) * ldn + sc)); }
#pragma unroll
    for (int i = 0; i < 16; ++i) { const int kk = 4 * i + (lane >> 4); f32x4 t = v[i]; if (g) t = t * g[k0 + kk];
        scr[kk * 65 + cg] = t[0]; scr[kk * 65 + cg + 1] = t[1]; scr[kk * 65 + cg + 2] = t[2]; scr[kk * 65 + cg + 3] = t[3]; }
    asm volatile("s_waitcnt lgkmcnt(0)" ::: "memory");
    const int c = lane & 7;
#pragma unroll
    for (int j = 0; j < 8; ++j) { const int n = (lane >> 3) + 8 * j; const LAS float* s = scr + (8 * c) * 65 + n;
        v4u o; o.x = pk2(s[0 * 65], s[1 * 65]); o.y = pk2(s[2 * 65], s[3 * 65]); o.z = pk2(s[4 * 65], s[5 * 65]); o.w = pk2(s[6 * 65], s[7 * 65]);
        *(v4u*)(WT + (size_t)(n0 + n) * K + k0 + 8 * c) = o; }
    asm volatile("s_waitcnt lgkmcnt(0)" ::: "memory");
}

template <bool HOLD_BF, bool HAS_F, bool WR_H, bool WR_XB, int NR> __device__ __forceinline__ void row_update(const void* hold, const bf16* F, const float* ss16, const float* __restrict__ g, float w, float* hout, bf16* xb, float* rstd_out, int row0, int rstride, int lane) {
    f32x4 v[NR][4]; v2u fv[NR][4]; float ssv[NR];
#pragma unroll
    for (int r = 0; r < NR; ++r) { const int row = row0 + r * rstride;
        if (HOLD_BF) { const v2u* hb = (const v2u*)((const bf16*)hold + (size_t)row * DM) + lane;
#pragma unroll
            for (int j = 0; j < 4; ++j) { const v2u t = hb[64 * j]; v[r][j] = (f32x4){bflo(t.x), bfhi(t.x), bflo(t.y), bfhi(t.y)}; } }
        else { const f32x4* hr = (const f32x4*)((const float*)hold + (size_t)row * DM) + lane;
#pragma unroll
            for (int j = 0; j < 4; ++j) v[r][j] = __builtin_nontemporal_load(hr + 64 * j); }
        if (HAS_F) { ssv[r] = ss16[(size_t)row * 16 + (lane & 15)]; const v2u* fr = (const v2u*)(F + (size_t)row * DM) + lane;
#pragma unroll
            for (int j = 0; j < 4; ++j) fv[r][j] = __builtin_nontemporal_load(fr + 64 * j); } }
    f32x4 gv[4];
    if (HAS_F) { const f32x4* gr = (const f32x4*)g + lane;
#pragma unroll
        for (int j = 0; j < 4; ++j) gv[j] = gr[64 * j]; }
#pragma unroll
    for (int r = 0; r < NR; ++r) { const int row = row0 + r * rstride;
        if (HAS_F) {
            float s = ssv[r];
            s += __shfl_xor(s, 1); s += __shfl_xor(s, 2); s += __shfl_xor(s, 4); s += __shfl_xor(s, 8);
            const float rf = w / sqrtf(s * (1.f / DM) + EPS);
#pragma unroll
            for (int j = 0; j < 4; ++j) { const v2u f = fv[r][j];
                v[r][j].x += bflo(f.x) * rf * gv[j].x; v[r][j].y += bfhi(f.x) * rf * gv[j].y; v[r][j].z += bflo(f.y) * rf * gv[j].z; v[r][j].w += bfhi(f.y) * rf * gv[j].w; }
        }
        if (WR_H) { f32x4* ho = (f32x4*)(hout + (size_t)row * DM) + lane;
#pragma unroll
            for (int j = 0; j < 4; ++j) __builtin_nontemporal_store(v[r][j], ho + 64 * j); }
        if (WR_XB) {
            float s2 = 0.f;
#pragma unroll
            for (int j = 0; j < 4; ++j) s2 += (v[r][j].x * v[r][j].x + v[r][j].y * v[r][j].y) + (v[r][j].z * v[r][j].z + v[r][j].w * v[r][j].w);
            s2 = wave_sum(s2);
            if (lane == 0) rstd_out[row] = 1.f / sqrtf(s2 * (1.f / DM) + EPS);
            v2u* xo = (v2u*)(xb + (size_t)row * DM) + lane;
#pragma unroll
            for (int j = 0; j < 4; ++j) { v2u o; o.x = pk2(v[r][j].x, v[r][j].y); o.y = pk2(v[r][j].z, v[r][j].w); xo[64 * j] = o; }
        }
    }
}
__device__ __forceinline__ void mem_row(const float* mem, const float* __restrict__ g, bf16* out, int row, int lane) {
    const f32x4* hr = (const f32x4*)(mem + (size_t)row * DM) + lane; const f32x4* gr = (const f32x4*)g + lane;
    f32x4 v[4]; float s2 = 0.f;
#pragma unroll
    for (int j = 0; j < 4; ++j) { v[j] = hr[64 * j]; s2 += (v[j].x * v[j].x + v[j].y * v[j].y) + (v[j].z * v[j].z + v[j].w * v[j].w); }
    const float r = 1.f / sqrtf(wave_sum(s2) * (1.f / DM) + EPS);
    v2u* xo = (v2u*)(out + (size_t)row * DM) + lane;
#pragma unroll
    for (int j = 0; j < 4; ++j) { const f32x4 gv = gr[64 * j]; v2u o; o.x = pk2(v[j].x * r * gv.x, v[j].y * r * gv.y); o.y = pk2(v[j].z * r * gv.z, v[j].w * r * gv.w); xo[64 * j] = o; }
}

__device__ __forceinline__ float ss8(v4u w) { float s = 0.f; const unsigned a[4] = {w.x, w.y, w.z, w.w};
#pragma unroll
    for (int e = 0; e < 4; ++e) { const float lo = bflo(a[e]), hi = bfhi(a[e]); s += lo * lo + hi * hi; } return s; }
__device__ __forceinline__ void fox_cumsum_unit(LAS float* scr, const float* SMALL, const float* b_f, float* CF, int bh, int tid) {
    const int b = bh >> 3, h = bh & 7; const float bfv = b_f[h];
    const f32x4* src = (const f32x4*)(SMALL + (size_t)h * T + (size_t)b * SEQ + (size_t)tid * 16);
    float v[16]; float run = 0.f;
#pragma unroll
    for (int e4 = 0; e4 < 4; ++e4) { const f32x4 xv = src[e4];
#pragma unroll
        for (int e = 0; e < 4; ++e) { run += logsig(xv[e] + bfv); v[e4 * 4 + e] = run; } }
    scr[tid] = run; __syncthreads();
    for (int off = 1; off < NTHR; off <<= 1) { const float t = (tid >= off) ? scr[tid - off] : 0.f; __syncthreads(); scr[tid] += t; __syncthreads(); }
    const float pre = scr[tid] - run;
    float* o = CF + (size_t)bh * SEQ + tid * 16;
#pragma unroll
    for (int e = 0; e < 16; e += 4) *(f32x4*)(o + e) = (f32x4){v[e] + pre, v[e + 1] + pre, v[e + 2] + pre, v[e + 3] + pre};
    __syncthreads();
}
__device__ __forceinline__ void fox_norm_unit(LAS float* scr, const bf16* Q, const bf16* K, unsigned* NQ, unsigned* NK, int unit, int tid) {
    const int bh = unit >> 3, seg = unit & 7, b = bh >> 3, h = bh & 7;
    float mq = 0.f, mk = 0.f;
#pragma unroll 8
    for (int r0 = 0; r0 < 1024; r0 += 64) { const size_t row = (size_t)b * SEQ + seg * 1024 + r0 + (tid >> 3);
        float sq = ss8(*(const v4u*)(Q + row * 1024 + h * 64 + (tid & 7) * 8)), sk = ss8(*(const v4u*)(K + row * 1024 + h * 64 + (tid & 7) * 8));
        sq += __shfl_xor(sq, 1); sq += __shfl_xor(sq, 2); sq += __shfl_xor(sq, 4); sk += __shfl_xor(sk, 1); sk += __shfl_xor(sk, 2); sk += __shfl_xor(sk, 4);
        mq = fmaxf(mq, sq); mk = fmaxf(mk, sk); }
#pragma unroll
    for (int o = 1; o < 64; o <<= 1) { mq = fmaxf(mq, __shfl_xor(mq, o)); mk = fmaxf(mk, __shfl_xor(mk, o)); }
    if ((tid & 63) == 0) { atomicMax(NQ + bh, __builtin_bit_cast(unsigned, mq)); atomicMax(NK + bh, __builtin_bit_cast(unsigned, mk)); }
}

#define LBAR() asm volatile("s_waitcnt lgkmcnt(0)\n\ts_barrier" ::: "memory")
constexpr int GL_BC = 0  , GL_GA = 16640  , GL_SEG = 20736  , GL_QD = 22784  , GL_KD = 32000, GL_AM = 41216,
              GL_VT = 50432  , GL_SPT = 68864  , GL_RS = 87296  , GL_GRL = 87808  ;
constexpr int GLP = 72, GOP = 136;
__device__ __forceinline__ int swz16(int r, int c) { return r * 72 + ((((c >> 3) ^ (r >> 4)) & 7) << 3) + (c & 7); }
__device__ __forceinline__ int swz8(int r, int c) { return r * 72 + ((((c >> 3) ^ (r >> 3)) & 7) << 3) + (c & 7); }
struct GlaW { float w[16]; float ba; };
__device__ __forceinline__ void gla_load_w(GlaW& W, const float* __restrict__ w_a2, const float* __restrict__ b_a, int h, int d) {
#pragma unroll
    for (int r = 0; r < 16; ++r) W.w[r] = w_a2[r * 256 + h * 64 + d];
    W.ba = b_a[h * 64 + d];
}
__device__ __forceinline__ void gla_logdecay(LAS unsigned char* lds, const GlaW& W, int tid) {
    LAS float* Bc = (LAS float*)(lds + GL_BC); const LAS float* ga = (const LAS float*)(lds + GL_GA); LAS float* sg = (LAS float*)(lds + GL_SEG);
    const int d = tid & 63, seg = tid >> 6;
    float vals[8]; float run = 0.f;
    const LAS f32x4* gp = (const LAS f32x4*)(ga + seg * 128);
    f32x4 gq[2][4];
#pragma unroll
    for (int q = 0; q < 4; ++q) gq[0][q] = gp[q];
#pragma unroll
    for (int k = 0; k < 8; ++k) {
        if (k < 7) {
#pragma unroll
            for (int q = 0; q < 4; ++q) gq[(k + 1) & 1][q] = gp[4 * (k + 1) + q]; }
            float x = W.ba;
#pragma unroll
        for (int q = 0; q < 4; ++q) { const f32x4 gv = gq[k & 1][q]; x += gv[0] * W.w[4 * q] + gv[1] * W.w[4 * q + 1] + gv[2] * W.w[4 * q + 2] + gv[3] * W.w[4 * q + 3]; }
        run += logsig(x) * (1.f / 16.f); vals[k] = run;
        }
    sg[seg * 64 + d] = run;
    LBAR();
    float pre = 0.f;
#pragma unroll
    for (int s2 = 0; s2 < 8; ++s2) { const float t = sg[s2 * 64 + d]; pre += (s2 < seg) ? t : 0.f; }
#pragma unroll
    for (int k = 0; k < 8; ++k) Bc[(seg * 8 + k) * 65 + d] = vals[k] + pre;
    LBAR();
}
__device__ __forceinline__ void gla_put_vt(LAS unsigned char* lds, const v4u a, const v4u b, int tid) {
    LAS bf16* VTl = (LAS bf16*)(lds + GL_VT);
    const int i = tid >> 3, vg = tid & 7;
    const unsigned wv[8] = {a.x, a.y, a.z, a.w, b.x, b.y, b.z, b.w};
#pragma unroll
    for (int e = 0; e < 8; ++e) { VTl[swz16(vg * 16 + 2 * e, i)] = (bf16)(wv[e] & 0xffffu); VTl[swz16(vg * 16 + 2 * e + 1, i)] = (bf16)(wv[e] >> 16); }
}
#define GLA_UNIT(u) const int h = (u) & 3, n = ((u) >> 2) & 127, b = (u) >> 9, row0 = b * SEQ + n * 64, bh = b * 4 + h
__device__ __forceinline__ void gla_prep_phase(LAS unsigned char* lds, const float* SMALL, const float* w_a2, const float* b_a, const bf16* GQK, const bf16* MIX, float* SCH, float* DEC, float* BCG, int first, int G, int tid) {
    if (first >= 2048) return;
    const int lane = tid & 63, wv = tid >> 6, l15 = lane & 15, fq = lane >> 4;
    LAS float* Bc = (LAS float*)(lds + GL_BC); LAS float* ga = (LAS float*)(lds + GL_GA); LAS bf16* KTE = (LAS bf16*)(lds + GL_QD); LAS bf16* VTl = (LAS bf16*)(lds + GL_VT);
    struct GpPre { float ga[2]; v4u k, v[2]; }; GpPre PA, PB;
#define GLA_LOADP(P, u) do { GLA_UNIT(u); (void)bh; (void)n; P.ga[0] = SMALL[(size_t)row0 * 16 + tid]; P.ga[1] = SMALL[(size_t)row0 * 16 + 512 + tid]; \
        P.k = *(const v4u*)(GQK + (size_t)(row0 + (tid >> 3)) * 512 + 256 + h * 64 + (tid & 7) * 8); \
        const v4u* vs_ = (const v4u*)(MIX + (size_t)(row0 + (tid >> 3)) * 1024 + 512 + h * 128 + (tid & 7) * 16); P.v[0] = vs_[0]; P.v[1] = vs_[1]; } while (0)
    GLA_LOADP(PA, first); if (first + G < 2048) GLA_LOADP(PB, first + G);
    GlaW W; int hcur = first & 3; gla_load_w(W, w_a2, b_a, hcur, tid & 63);
#define GLA_PREP_BODY(P, U_, UN_) do { \
        GLA_UNIT(U_); \
        LAS unsigned char* lz = lds; asm volatile("" : "+v"(lz)); \
        LAS float* Bc = (LAS float*)(lz + GL_BC); LAS float* ga = (LAS float*)(lz + GL_GA); LAS bf16* KTE = (LAS bf16*)(lz + GL_QD); LAS bf16* VTl = (LAS bf16*)(lz + GL_VT); \
        if (h != hcur) { hcur = h; gla_load_w(W, w_a2, b_a, hcur, tid & 63); } \
        ga[tid] = P.ga[0]; ga[512 + tid] = P.ga[1]; \
        gla_put_vt(lz, P.v[0], P.v[1], tid); \
        const v4u kP = P.k; if ((UN_) < 2048) GLA_LOADP(P, UN_); \
        LBAR(); \
        gla_logdecay(lz, W, tid); \
        { const int i_ = tid >> 3, dg_ = tid & 7; const LAS float* bs_ = Bc + i_ * 65 + dg_ * 8; float* bd_ = BCG + ((size_t)(U_) * 64 + i_) * 64 + dg_ * 8; \
          __builtin_nontemporal_store(((f32x4){bs_[0], bs_[1], bs_[2], bs_[3]}), (f32x4*)bd_); __builtin_nontemporal_store(((f32x4){bs_[4], bs_[5], bs_[6], bs_[7]}), (f32x4*)(bd_ + 4)); } \
        { const int i = tid >> 3, dg = tid & 7; const unsigned kw[4] = {kP.x, kP.y, kP.z, kP.w}; \
_Pragma("unroll") \
          for (int e = 0; e < 4; ++e) { const int d = dg * 8 + 2 * e; \
              const float e0 = __expf(Bc[63 * 65 + d] - Bc[i * 65 + d]), e1 = __expf(Bc[63 * 65 + d + 1] - Bc[i * 65 + d + 1]); \
              KTE[swz8(d, i)] = (bf16)f2bf(bflo(kw[e]) * e0); KTE[swz8(d + 1, i)] = (bf16)f2bf(bfhi(kw[e]) * e1); } } \
        if (tid < 64) DEC[((size_t)bh * 128 + n) * 64 + tid] = __expf(Bc[63 * 65 + tid]); \
        LBAR(); \
        f32x4 acc[4]; \
_Pragma("unroll") \
        for (int mb = 0; mb < 4; ++mb) acc[mb] = (f32x4){0.f, 0.f, 0.f, 0.f}; \
        bf16x8 bfr_[2], afr_[2][4]; \
_Pragma("unroll") \
        for (int ks = 0; ks < 2; ++ks) { bfr_[ks] = *(const LAS bf16x8*)(VTl + swz16(16 * wv + l15, ks * 32 + 8 * fq)); \
_Pragma("unroll") \
            for (int mb = 0; mb < 4; ++mb) afr_[ks][mb] = *(const LAS bf16x8*)(KTE + swz8(16 * mb + l15, ks * 32 + 8 * fq)); } \
        __builtin_amdgcn_sched_barrier(0); \
_Pragma("unroll") \
        for (int ks = 0; ks < 2; ++ks) \
_Pragma("unroll") \
            for (int mb = 0; mb < 4; ++mb) acc[mb] = __builtin_amdgcn_mfma_f32_16x16x32_bf16(afr_[ks][mb], bfr_[ks], acc[mb], 0, 0, 0); \
        __builtin_amdgcn_sched_barrier(0); \
        float* dst = SCH + (((size_t)bh * 128 + n) * 64) * 128 + 16 * wv + l15; \
_Pragma("unroll") \
        for (int mb = 0; mb < 4; ++mb) \
_Pragma("unroll") \
            for (int j = 0; j < 4; ++j) __builtin_nontemporal_store(acc[mb][j], dst + (size_t)(16 * mb + 4 * fq + j) * 128); \
        LBAR(); \
    } while (0)
    for (int u = first; u < 2048; u += 2 * G) { GLA_PREP_BODY(PA, u, u + 2 * G); if (u + G < 2048) GLA_PREP_BODY(PB, u + G, u + 3 * G); }
#undef GLA_PREP_BODY
#undef GLA_LOADP
}
__device__ __forceinline__ void gla_out_phase(LAS unsigned char* lds, const float* BCG, const bf16* GQK, const bf16* MIX, bf16* OUT, const bf16* GR, const bf16* SCH, const float* __restrict__ g_gla, int first, int G, int tid) {
    if (first >= 2048) return;
    const int lane = tid & 63, wv = tid >> 6, l15 = lane & 15, fq = lane >> 4, mb = wv >> 1;
    LAS float* Bc = (LAS float*)(lds + GL_BC); LAS float* ga = (LAS float*)(lds + GL_GA); LAS bf16* QD = (LAS bf16*)(lds + GL_QD); LAS bf16* KD = (LAS bf16*)(lds + GL_KD); LAS bf16* AM = (LAS bf16*)(lds + GL_AM);
    LAS bf16* VTl = (LAS bf16*)(lds + GL_VT); LAS bf16* SPT = (LAS bf16*)(lds + GL_SPT); LAS float* RS = (LAS float*)(lds + GL_RS); LAS bf16* GRL = (LAS bf16*)(lds + GL_GRL); LAS bf16* OST = (LAS bf16*)(lds + GL_QD);
    struct GoPre { f32x4 bc[2]; v4u q, k, v[2], gr[2], s[2]; }; GoPre PA;
#define GLA_LOADP(P, u) do { GLA_UNIT(u); { const f32x4* bb_ = (const f32x4*)(BCG + ((size_t)(u) * 64 + (tid >> 3)) * 64 + (tid & 7) * 8); P.bc[0] = __builtin_nontemporal_load(bb_); P.bc[1] = __builtin_nontemporal_load(bb_ + 1); } \
        P.q = *(const v4u*)(GQK + (size_t)(row0 + (tid >> 3)) * 512 + h * 64 + (tid & 7) * 8); P.k = *(const v4u*)(GQK + (size_t)(row0 + (tid >> 3)) * 512 + 256 + h * 64 + (tid & 7) * 8); \
        const v4u* vs_ = (const v4u*)(MIX + (size_t)(row0 + (tid >> 3)) * 1024 + 512 + h * 128 + (tid & 7) * 16); P.v[0] = vs_[0]; P.v[1] = vs_[1]; \
        const v4u* gs_ = (const v4u*)(GR + (size_t)(row0 + (tid >> 3)) * 512 + h * 128 + (tid & 7) * 16); P.gr[0] = gs_[0]; P.gr[1] = gs_[1]; \
        const v4u* ss_ = (const v4u*)(SCH + (((size_t)bh * 128 + n) * 64 + (tid >> 3)) * 128 + (tid & 7) * 16); P.s[0] = __builtin_nontemporal_load(ss_); P.s[1] = __builtin_nontemporal_load(ss_ + 1); } while (0)
    GLA_LOADP(PA, first);
    int hcur = first & 3;
    float gg[4];
#pragma unroll
    for (int t4 = 0; t4 < 4; ++t4) gg[t4] = g_gla[hcur * 128 + 16 * ((wv & 1) * 4 + t4) + l15];
#define GLA_OUT_BODY(P, U_, UN_) do { \
        GLA_UNIT(U_); (void)bh; (void)n; \
        LAS unsigned char* lz = lds; asm volatile("" : "+v"(lz)); \
        LAS float* Bc = (LAS float*)(lz + GL_BC); LAS float* ga = (LAS float*)(lz + GL_GA); LAS bf16* QD = (LAS bf16*)(lz + GL_QD); LAS bf16* KD = (LAS bf16*)(lz + GL_KD); LAS bf16* AM = (LAS bf16*)(lz + GL_AM); \
        LAS bf16* VTl = (LAS bf16*)(lz + GL_VT); LAS bf16* SPT = (LAS bf16*)(lz + GL_SPT); LAS float* RS = (LAS float*)(lz + GL_RS); LAS bf16* GRL = (LAS bf16*)(lz + GL_GRL); LAS bf16* OST = (LAS bf16*)(lz + GL_QD); \
        if (h != hcur) { hcur = h; \
_Pragma("unroll") \
            for (int t4 = 0; t4 < 4; ++t4) gg[t4] = g_gla[hcur * 128 + 16 * ((wv & 1) * 4 + t4) + l15]; } \
        { LAS float* bw_ = Bc + (tid >> 3) * 65 + (tid & 7) * 8; bw_[0] = P.bc[0][0]; bw_[1] = P.bc[0][1]; bw_[2] = P.bc[0][2]; bw_[3] = P.bc[0][3]; bw_[4] = P.bc[1][0]; bw_[5] = P.bc[1][1]; bw_[6] = P.bc[1][2]; bw_[7] = P.bc[1][3]; } \
        gla_put_vt(lz, P.v[0], P.v[1], tid); \
        { const int d = tid >> 3, vg = tid & 7; \
          { const unsigned sw_[8] = {P.s[0].x, P.s[0].y, P.s[0].z, P.s[0].w, P.s[1].x, P.s[1].y, P.s[1].z, P.s[1].w}; \
_Pragma("unroll") \
            for (int e = 0; e < 8; ++e) { SPT[swz16(vg * 16 + 2 * e, d)] = (bf16)(sw_[e] & 0xffffu); SPT[swz16(vg * 16 + 2 * e + 1, d)] = (bf16)(sw_[e] >> 16); } } \
          *(LAS v4u*)(GRL + (tid >> 3) * GOP + vg * 16) = P.gr[0]; *(LAS v4u*)(GRL + (tid >> 3) * GOP + vg * 16 + 8) = P.gr[1]; } \
        const v4u qP = P.q, kP = P.k; if ((UN_) < 2048) GLA_LOADP(P, UN_); \
        LBAR(); \
        { const int i = tid >> 3, dg = tid & 7; \
          const unsigned qw[4] = {qP.x, qP.y, qP.z, qP.w}, kw[4] = {kP.x, kP.y, kP.z, kP.w}; \
          unsigned qo[4], ko[4]; \
_Pragma("unroll") \
          for (int e = 0; e < 4; ++e) { const int d = dg * 8 + 2 * e; const float b0 = Bc[i * 65 + d], b1 = Bc[i * 65 + d + 1]; \
              qo[e] = pk2(bflo(qw[e]) * 0.125f * __expf(b0), bfhi(qw[e]) * 0.125f * __expf(b1)); \
              ko[e] = pk2(bflo(kw[e]) * __expf(-b0), bfhi(kw[e]) * __expf(-b1)); } \
          *(LAS v4u*)(QD + i * GLP + dg * 8) = (v4u){qo[0], qo[1], qo[2], qo[3]}; \
          *(LAS v4u*)(KD + i * GLP + dg * 8) = (v4u){ko[0], ko[1], ko[2], ko[3]}; } \
        LBAR(); \
        bf16x8 qa_[2], kb_[2][2]; \
_Pragma("unroll") \
        for (int ks = 0; ks < 2; ++ks) { qa_[ks] = *(const LAS bf16x8*)(QD + (16 * mb + l15) * GLP + ks * 32 + 8 * fq); \
_Pragma("unroll") \
            for (int t2 = 0; t2 < 2; ++t2) kb_[t2][ks] = *(const LAS bf16x8*)(KD + (16 * ((wv & 1) * 2 + t2) + l15) * GLP + ks * 32 + 8 * fq); } \
        __builtin_amdgcn_sched_barrier(0); \
_Pragma("unroll") \
        for (int t2 = 0; t2 < 2; ++t2) { const int nbj = (wv & 1) * 2 + t2; f32x4 a = (f32x4){0.f, 0.f, 0.f, 0.f}; \
_Pragma("unroll") \
            for (int ks = 0; ks < 2; ++ks) a = __builtin_amdgcn_mfma_f32_16x16x32_bf16(qa_[ks], kb_[t2][ks], a, 0, 0, 0); \
_Pragma("unroll") \
            for (int j = 0; j < 4; ++j) { const int i = 16 * mb + 4 * fq + j, jj = 16 * nbj + l15; AM[i * GLP + jj] = (bf16)f2bf(jj <= i ? a[j] : 0.f); } } \
        LBAR(); \
        f32x4 acc[4]; \
_Pragma("unroll") \
        for (int t4 = 0; t4 < 4; ++t4) acc[t4] = (f32x4){0.f, 0.f, 0.f, 0.f}; \
_Pragma("unroll") \
        for (int ks = 0; ks < 2; ++ks) { bf16x8 fA, fQ, fV[4], fS[4]; \
            fA = *(const LAS bf16x8*)(AM + (16 * mb + l15) * GLP + ks * 32 + 8 * fq); fQ = *(const LAS bf16x8*)(QD + (16 * mb + l15) * GLP + ks * 32 + 8 * fq); \
_Pragma("unroll") \
            for (int t4 = 0; t4 < 4; ++t4) { const int nb = (wv & 1) * 4 + t4; \
                fV[t4] = *(const LAS bf16x8*)(VTl + swz16(16 * nb + l15, ks * 32 + 8 * fq)); fS[t4] = *(const LAS bf16x8*)(SPT + swz16(16 * nb + l15, ks * 32 + 8 * fq)); } \
            __builtin_amdgcn_sched_barrier(0); \
_Pragma("unroll") \
            for (int t4 = 0; t4 < 4; ++t4) { acc[t4] = __builtin_amdgcn_mfma_f32_16x16x32_bf16(fA, fV[t4], acc[t4], 0, 0, 0); acc[t4] = __builtin_amdgcn_mfma_f32_16x16x32_bf16(fQ, fS[t4], acc[t4], 0, 0, 0); } \
            __builtin_amdgcn_sched_barrier(0); } \
_Pragma("unroll") \
        for (int j = 0; j < 4; ++j) { float s = 0.f; \
_Pragma("unroll") \
            for (int t4 = 0; t4 < 4; ++t4) s += acc[t4][j] * acc[t4][j]; \
            s += __shfl_xor(s, 1); s += __shfl_xor(s, 2); s += __shfl_xor(s, 4); s += __shfl_xor(s, 8); \
            if (l15 == 0) RS[(16 * mb + 4 * fq + j) * 2 + (wv & 1)] = s; } \
        LBAR(); \
        float rs_[4][2]; bf16 gt_[4][4]; \
_Pragma("unroll") \
        for (int j = 0; j < 4; ++j) { const int i = 16 * mb + 4 * fq + j; rs_[j][0] = RS[i * 2]; rs_[j][1] = RS[i * 2 + 1]; \
_Pragma("unroll") \
            for (int t4 = 0; t4 < 4; ++t4) gt_[j][t4] = GRL[i * GOP + 16 * ((wv & 1) * 4 + t4) + l15]; } \
        __builtin_amdgcn_sched_barrier(0); \
_Pragma("unroll") \
        for (int j = 0; j < 4; ++j) { const int i = 16 * mb + 4 * fq + j; const float rinv = __builtin_amdgcn_rsqf((rs_[j][0] + rs_[j][1]) * (1.f / 128.f) + EPS); \
_Pragma("unroll") \
            for (int t4 = 0; t4 < 4; ++t4) { const int c = 16 * ((wv & 1) * 4 + t4) + l15; \
                OST[i * GOP + c] = (bf16)f2bf(acc[t4][j] * rinv * gg[t4] * silu1(bf2f(gt_[j][t4]))); } } \
        LBAR(); \
_Pragma("unroll") \
        for (int k = 0; k < 2; ++k) { const int c = tid + NTHR * k, r = c >> 4, ch = c & 15; \
            *(v4u*)(OUT + (size_t)(row0 + r) * 1024 + 512 + h * 128 + ch * 8) = *(const LAS v4u*)(OST + r * GOP + ch * 8); } \
    } while (0)
    for (int u = first; u < 2048; u += G) GLA_OUT_BODY(PA, u, u + G);
#undef GLA_OUT_BODY
#undef GLA_LOADP
}
#undef GLA_UNIT

constexpr int XA_STAGE = 69632  , XA_V = 32768, XA_VP = 72;
template <class Sched> __device__ __forceinline__ void xattn_phase(LAS unsigned char* lds, const bf16* QM, const bf16* KM, const bf16* VT, bf16* OM, const Sched& S, int tid) {
    pg8::Unit gu_;
#define XA_UNIT(idx) (S.next((idx) >> 1, gu_) ? (((gu_.pm >> 5) << 8) | (gu_.pn << 6) | (((gu_.pm & 31) << 1) + ((idx) & 1))) : -1)
    const int first = XA_UNIT(0);
    if (first < 0) return;
    const int lane = tid & 63, wv = tid >> 6, l15 = lane & 15, fq = lane >> 4;
    v4u pk[4], pv[4];
#define XA_LOAD(u, kt) do { const int h_ = ((u) >> 6) & 3, b_ = (u) >> 8; _Pragma("unroll") for (int i = 0; i < 4; ++i) { const int p = tid + NTHR * i; \
        pk[i] = *(const v4u*)(KM + (size_t)(b_ * 256 + (kt) * 64 + (p >> 5)) * 1024 + h_ * 256 + (p & 31) * 8); \
        pv[i] = *(const v4u*)(VT + (size_t)(h_ * 256 + (p >> 3)) * 1024 + b_ * 256 + (kt) * 64 + (p & 7) * 8); } } while (0)
#define XA_STORE(buf) do { LAS unsigned char* st_ = lds + (buf) * XA_STAGE; _Pragma("unroll") for (int i = 0; i < 4; ++i) { const int p = tid + NTHR * i; \
        *(LAS v4u*)(st_ + (p & 31) * 1024 + (p >> 5) * 16) = pk[i]; *(LAS v4u*)(st_ + XA_V + (p >> 3) * (XA_VP * 2) + (p & 7) * 16) = pv[i]; } } while (0)
    XA_LOAD(first, 0); XA_STORE(0);
    LBAR();
    int buf = 0;
    int unext = first;
    for (int idx = 0; unext >= 0; ++idx) {
        const int u = unext; unext = XA_UNIT(idx + 1);
        const int qblk = u & 63, h = (u >> 6) & 3, b = u >> 8;
        const int row0 = b * SEQ + qblk * 128 + wv * 16;
        bf16x8 qf[8];
#pragma unroll
        for (int s = 0; s < 8; ++s) qf[s] = *(const bf16x8*)(QM + (size_t)(row0 + l15) * 1024 + h * 256 + s * 32 + 8 * fq);
        float mrun = -1e30f, lrun = 0.f; f32x4 o[16];
#pragma unroll
        for (int db = 0; db < 16; ++db) o[db] = (f32x4){0.f, 0.f, 0.f, 0.f};
        for (int kt = 0; kt < 4; ++kt) {
            const bool more = (kt < 3) || (unext >= 0);
            if (more) { if (kt < 3) XA_LOAD(u, kt + 1); else XA_LOAD(unext, 0); }
            const LAS unsigned char* st = lds + buf * XA_STAGE;
            const LAS unsigned char* kbase = st + fq * 1024 + l15 * 16; const LAS unsigned char* vbase = st + XA_V + l15 * (XA_VP * 2) + 8 * fq;
#define XA_RDS(F, b) do { _Pragma("unroll") for (int kb = 0; kb < 4; ++kb) F[kb] = *(const LAS bf16x8*)(kbase + (b) * 4096 + kb * 256); } while (0)
#define XA_MMS(F, b) do { _Pragma("unroll") for (int kb = 0; kb < 4; ++kb) s[kb] = __builtin_amdgcn_mfma_f32_16x16x32_bf16(F[kb], qf[b], s[kb], 0, 0, 0); } while (0)
#define XA_RDV(F, b) do { _Pragma("unroll") for (int d4 = 0; d4 < 4; ++d4) { const LAS unsigned char* vp = vbase + (16 * (4 * ((b) & 3) + d4)) * (XA_VP * 2) + 64 * ((b) >> 2); \
        const v2u lo = *(const LAS v2u*)vp, hi = *(const LAS v2u*)(vp + 32); F[d4] = __builtin_bit_cast(bf16x8, ((v4u){lo.x, lo.y, hi.x, hi.y})); } } while (0)
#define XA_MMO(F, b) do { _Pragma("unroll") for (int d4 = 0; d4 < 4; ++d4) o[4 * ((b) & 3) + d4] = __builtin_amdgcn_mfma_f32_16x16x32_bf16(F[d4], pb[(b) >> 2], o[4 * ((b) & 3) + d4], 0, 0, 0); } while (0)
#define XA_SB() __builtin_amdgcn_sched_barrier(0)
            bf16x8 fa[4], fb[4];
            f32x4 s[4];
#pragma unroll
            for (int kb = 0; kb < 4; ++kb) s[kb] = (f32x4){0.f, 0.f, 0.f, 0.f};
            XA_RDS(fa, 0); XA_SB();
            XA_RDS(fb, 1); XA_SB(); XA_MMS(fa, 0); XA_SB();
            XA_RDS(fa, 2); XA_SB(); XA_MMS(fb, 1); XA_SB();
            XA_RDS(fb, 3); XA_SB(); XA_MMS(fa, 2); XA_SB();
            XA_RDS(fa, 4); XA_SB(); XA_MMS(fb, 3); XA_SB();
            XA_RDS(fb, 5); XA_SB(); XA_MMS(fa, 4); XA_SB();
            XA_RDS(fa, 6); XA_SB(); XA_MMS(fb, 5); XA_SB();
            XA_RDS(fb, 7); XA_SB(); XA_MMS(fa, 6); XA_SB();
            XA_RDV(fa, 0); XA_SB(); XA_MMS(fb, 7); XA_SB();
            float mx = fmaxf(fmaxf(fmaxf(s[0][0], s[0][1]), fmaxf(s[0][2], s[0][3])), fmaxf(fmaxf(s[1][0], s[1][1]), fmaxf(s[1][2], s[1][3])));
            mx = fmaxf(mx, fmaxf(fmaxf(fmaxf(s[2][0], s[2][1]), fmaxf(s[2][2], s[2][3])), fmaxf(fmaxf(s[3][0], s[3][1]), fmaxf(s[3][2], s[3][3]))));
            mx = fmaxf(mx, __shfl_xor(mx, 16)); mx = fmaxf(mx, __shfl_xor(mx, 32));
            const float mnew = fmaxf(mrun, mx), alpha = __builtin_amdgcn_exp2f(mrun - mnew); mrun = mnew;
            float psum = 0.f;
#pragma unroll
            for (int kb = 0; kb < 4; ++kb)
#pragma unroll
                for (int j = 0; j < 4; ++j) { s[kb][j] = __builtin_amdgcn_exp2f(s[kb][j] - mnew); psum += s[kb][j]; }
            lrun = lrun * alpha + psum;
#pragma unroll
            for (int db = 0; db < 16; ++db) o[db] *= alpha;
            bf16x8 pb[2];
#pragma unroll
            for (int g = 0; g < 2; ++g) { v4u pw; pw.x = pk2(s[2 * g][0], s[2 * g][1]); pw.y = pk2(s[2 * g][2], s[2 * g][3]); pw.z = pk2(s[2 * g + 1][0], s[2 * g + 1][1]); pw.w = pk2(s[2 * g + 1][2], s[2 * g + 1][3]);
                pb[g] = __builtin_bit_cast(bf16x8, pw); }
            XA_SB();
            XA_RDV(fb, 1); XA_SB(); XA_MMO(fa, 0); XA_SB();
            XA_RDV(fa, 2); XA_SB(); XA_MMO(fb, 1); XA_SB();
            XA_RDV(fb, 3); XA_SB(); XA_MMO(fa, 2); XA_SB();
            XA_RDV(fa, 4); XA_SB(); XA_MMO(fb, 3); XA_SB();
            XA_RDV(fb, 5); XA_SB(); XA_MMO(fa, 4); XA_SB();
            XA_RDV(fa, 6); XA_SB(); XA_MMO(fb, 5); XA_SB();
            XA_RDV(fb, 7); XA_SB(); XA_MMO(fa, 6); XA_SB();
            XA_MMO(fb, 7); XA_SB();
#undef XA_RDS
#undef XA_MMS
#undef XA_RDV
#undef XA_MMO
#undef XA_SB
            if (more) XA_STORE(buf ^ 1);
            LBAR();
            buf ^= 1;
        }
        lrun += __shfl_xor(lrun, 16); lrun += __shfl_xor(lrun, 32);
        const float rl = 1.f / lrun;
        bf16* orow = OM + (size_t)(row0 + l15) * 1024 + h * 256 + 4 * fq;
#pragma unroll
        for (int db = 0; db < 16; ++db) { v2u w; w.x = pk2(o[db][0] * rl, o[db][1] * rl); w.y = pk2(o[db][2] * rl, o[db][3] * rl); *(v2u*)(orow + 16 * db) = w; }
    }
#undef XA_LOAD
#undef XA_STORE
#undef XA_UNIT
}

struct Args { const float* in[24]; float* out; unsigned char* ws; int ph_lo, ph_hi; };
__global__ void __launch_bounds__(NTHR, 2) layer_fwd(Args args) {
    extern __shared__ __attribute__((aligned(16))) unsigned char lds_raw[];
    LAS unsigned char* lds = (LAS unsigned char*)lds_raw;
    const int tid = threadIdx.x, lane = tid & 63, wave = __builtin_amdgcn_readfirstlane(tid >> 6);
    const int G = gridDim.x, bx = blockIdx.x;
    const int vcu = (G % 8 == 0) ? (bx % 8) * (G / 8) + bx / 8 : bx;
    const int gw = vcu * NWAVES + wave, NGW = G * NWAVES;
    unsigned char* ws = args.ws;
    bf16 *W_GU1 = (bf16*)(ws + WS_WGU1), *W_D1 = (bf16*)(ws + WS_WD1), *W_IN = (bf16*)(ws + WS_WIN), *W_OUT = (bf16*)(ws + WS_WOUT), *W_MQ = (bf16*)(ws + WS_WMQ), *W_MKV = (bf16*)(ws + WS_WMKV),
         *W_MO = (bf16*)(ws + WS_WMO), *W_GU2 = (bf16*)(ws + WS_WGU2), *W_D2 = (bf16*)(ws + WS_WD2), *MEMN = (bf16*)(ws + WS_MEMN), *KM = (bf16*)(ws + WS_KM), *VTm = (bf16*)(ws + WS_VT),
         *XB = (bf16*)(ws + WS_XB), *FB = (bf16*)(ws + WS_FB), *GR = (bf16*)(ws + WS_GR), *ACT = (bf16*)(ws + WS_ACT), *MIX = (bf16*)(ws + WS_MIX), *KV = (bf16*)(ws + WS_KV), *GQK = (bf16*)(ws + WS_GQK),
         *QM = (bf16*)(ws + WS_QM), *OM = (bf16*)(ws + WS_OM);
    float *RSTD = (float*)(ws + WS_RSTD), *ROWSS = (float*)(ws + WS_ROWSS), *SMALL = (float*)(ws + WS_SMALL), *CF = (float*)(ws + WS_CF), *DEC = (float*)(ws + WS_DEC), *SCH = (float*)(ws + WS_SCH), *UB = (float*)(ws + WS_UB), *FZT = SMALL + (size_t)T * 16, *BCG = (float*)(ws + WS_BCG); unsigned* NQK = (unsigned*)(ws + WS_CTL) + 8192;
    const int lo = args.ph_lo, hi = args.ph_hi;
    volatile LAS unsigned* MISC = (volatile LAS unsigned*)(lds + MISC_OFF);
    if (tid < 32) MISC[tid] = 0u;
    __syncthreads();
    (void)xcd_barrier_post((unsigned*)(ws + WS_CTL) + 1024, MISC + 8);
    if (hi > NPH) cg::this_grid().sync();
#define IN(k) (lo <= (k) && (k) < hi)
#ifndef PROBE
#define PROBE 0
#endif
#ifndef GEMM_ALIGN
#define GEMM_ALIGN true
#endif
#ifndef GEMM_SP2
#define GEMM_SP2 true
#endif
#ifndef GU_ALIGN
#define GU_ALIGN true
#endif
#define PRB(n) (PROBE == (n))
#define REP(n) for (int rep_ = 0; rep_ < (PRB(n) ? 2 : 1); ++rep_)
#define SEAM(k) do { if (IN(k) && IN((k) + 1)) { XcdBarrier b_; b_.bar = (unsigned*)(args.ws + WS_CTL) + 1024; b_.x = xb_xcc_id(); b_.st = (volatile LAS unsigned*)(lds + MISC_OFF) + 8; xcd_barrier(b_); if (PRB(1)) xcd_barrier(b_); } } while (0)

    if (IN(0)) REP(4) {
        LAS float* scr = (LAS float*)(lds + wave * 17408);
        constexpr int I_GU = (DM / 64) * (NGU / 64), I_D = (FF / 64) * (DM / 64), I_IN = (DM / 64) * (NIN / 64), I_SQ = (DM / 64) * (DM / 64), I_KV = (DM / 64) * (2048 / 64);
        constexpr int NITEMS = I_GU + I_D + I_IN + I_KV;
        for (int r12 = 0; r12 < (PRB(12) ? 2 : 1); ++r12)
        for (int it = gw; it < NITEMS; it += NGW) {
            int r = it;
            if (r < I_GU) { transpose_item<1>(args.in[3], NGU, DM, W_GU1, args.in[2], scr, r, NGU / 64, lane); continue; } r -= I_GU;
            if (r < I_D) { transpose_item<0>(args.in[4], DM, FF, W_D1, nullptr, scr, r, DM / 64, lane); continue; } r -= I_D;
            if (r < I_IN) { transpose_item<2>(args.in[7], 3096, DM, W_IN, args.in[6], scr, r, NIN / 64, lane); continue; } r -= I_IN;
            transpose_item<0>(args.in[17], 2048, DM, W_MKV, nullptr, scr, r, 2048 / 64, lane);
        }
        for (int r13 = 0; r13 < (PRB(13) ? 2 : 1); ++r13)
        for (int m = gw; m < T; m += 2 * NGW) row_update<false, false, false, true, 2>(args.in[0], nullptr, nullptr, nullptr, 0.f, nullptr, XB, RSTD, m, NGW, lane);
        for (int m = gw; m < 1024; m += NGW) mem_row(args.in[1], args.in[15], MEMN, m, lane);
    }
    SEAM(0);
    if (IN(1)) REP(6) { pg8::Gemm g{XB, W_GU1, T, NGU, DM}; pg8::StaticOrder S; S.init(T, NGU, G, bx); pg8::EpiSwiGLU E{ACT, FF, RSTD};
        pg8::gemm_phase<pg8::EpiSwiGLU, pg8::StaticOrder, GU_ALIGN, GEMM_SP2>(lds, g, S, E); }
    SEAM(1);
    if (IN(2)) REP(6) { pg8::Gemm g{ACT, W_D1, T, DM, FF}; pg8::StaticOrder S; S.init(T, DM, G, bx); pg8::EpiRowSS E{FB, DM, ROWSS};
        pg8::gemm_phase<pg8::EpiRowSS, pg8::StaticOrder, GEMM_ALIGN, GEMM_SP2>(lds, g, S, E); }
    SEAM(2);
    if (IN(3)) REP(10) { for (int m = gw; m < T; m += 2 * NGW) row_update<false, true, false, true, 2>(args.in[0], FB, ROWSS, args.in[5], 0.5f, nullptr, XB, RSTD, m, NGW, lane); }
    SEAM(3);
    if (IN(4)) { pg8::Gemm g{XB, W_IN, T, NIN, DM}; pg8::StaticOrder S; S.init(T, NIN, G, bx); pg8::EpiInProj E{MIX, KV, GQK, GR, SMALL, FZT, RSTD, 0.125f * LOG2E};
        pg8::gemm_phase<pg8::EpiInProj, pg8::StaticOrder, GEMM_ALIGN, GEMM_SP2>(lds, g, S, E);
        const int nu4 = (T / 256) * (NIN / 256), slot = (nu4 % G) ? bx - (nu4 % G) : bx;
        { const bool mine = slot >= 0 && slot < 16; pg8::Gemm gk{MEMN, W_MKV, 1024, DM, DM}; pg8::OneUnit S1{mine ? slot >> 2 : 0, mine ? slot & 3 : 0, mine}; pg8::EpiScale Ek{KM, DM, nullptr, 1.f};
          pg8::gemm_phase<pg8::EpiScale, pg8::OneUnit, true, true>(lds, gk, S1, Ek); }
        { const bool mine = slot >= 16 && slot < 32; pg8::Gemm gv{W_MKV + (size_t)1024 * DM, MEMN, 1024, 1024, DM}; pg8::OneUnit S2{mine ? (slot - 16) >> 2 : 0, mine ? (slot - 16) & 3 : 0, mine}; pg8::EpiScale Ev{VTm, 1024, nullptr, 1.f};
          pg8::gemm_phase<pg8::EpiScale, pg8::OneUnit, true, true>(lds, gv, S2, Ev); }
        { const int nidle = (nu4 % G) ? G - (nu4 % G) - 32 : 0, rank = slot - 32;
          if (nidle > 0 && rank >= 0) {
              LAS float* scr = (LAS float*)(lds + wave * 17408);
              constexpr int I_GU = (DM / 64) * (NGU / 64), I_D = (FF / 64) * (DM / 64), I_SQ = (DM / 64) * (DM / 64);
              for (int it = rank * NWAVES + wave; it < I_GU + I_D + 3 * I_SQ; it += nidle * NWAVES) {
                  int r = it;
                  if (r < I_GU) { transpose_item<1>(args.in[21], NGU, DM, W_GU2, args.in[20], scr, r, NGU / 64, lane); continue; } r -= I_GU;
                  if (r < I_D) { transpose_item<0>(args.in[22], DM, FF, W_D2, nullptr, scr, r, DM / 64, lane); continue; } r -= I_D;
                  if (r < I_SQ) { transpose_item<0>(args.in[12], DM, DM, W_OUT, nullptr, scr, r, DM / 64, lane); continue; } r -= I_SQ;
                  if (r < I_SQ) { transpose_item<0>(args.in[16], DM, DM, W_MQ, args.in[14], scr, r, DM / 64, lane); continue; } r -= I_SQ;
                  transpose_item<0>(args.in[18], DM, DM, W_MO, nullptr, scr, r, DM / 64, lane);
              }
          }
        }
    }
    SEAM(4);
    if (IN(5)) REP(2) {
        for (int r9 = 0; r9 < (PRB(9) ? 2 : 1); ++r9) {
        for (int u = bx; u < 256; u += G) fox_norm_unit((LAS float*)lds, MIX, KV, NQK, NQK + 32, u, tid);
        for (int u = bx; u < 32; u += G) fox_cumsum_unit((LAS float*)lds, FZT, args.in[10], CF, u, tid);
        }
        for (int r7 = 0; r7 < (PRB(7) ? 2 : 1); ++r7) { gla_prep_phase(lds, SMALL, args.in[8], args.in[9], GQK, MIX, SCH, DEC, BCG, bx, G, tid); __syncthreads(); }
    }
    SEAM(5);
    if (IN(6)) {
        for (int r11 = 0; r11 < (PRB(11) ? 2 : 1); ++r11)
        for (size_t e = (size_t)bx * NTHR + tid; e < (size_t)16 * 8192; e += (size_t)G * NTHR) {
            const int bh = (int)(e >> 13), dv = (int)(e & 8191), d = dv >> 7;
            const float* p = SCH + (size_t)bh * 128 * 8192 + dv; bf16* po = FB + (size_t)bh * 128 * 8192 + dv; const float* dc = DEC + (size_t)bh * 128 * 64 + d;
            float st = 0.f;
            for (int n0 = 0; n0 < 128; n0 += 16) { float tv[16], dd[16];
#pragma unroll
                for (int k = 0; k < 16; ++k) { tv[k] = __builtin_nontemporal_load(p + (size_t)(n0 + k) * 8192); dd[k] = dc[(n0 + k) * 64]; }
#pragma unroll
                for (int k = 0; k < 16; ++k) { __builtin_nontemporal_store((bf16)f2bf(st), po + (size_t)(n0 + k) * 8192); st = dd[k] * st + tv[k]; } }
        }
        __syncthreads();
        REP(5) {
        const attn_body::AttnTensors AT{(const attn_body::bf16*)MIX, (const attn_body::bf16*)KV, (const attn_body::bf16*)(KV + 512), (attn_body::bf16*)(PRB(5) && rep_ == 0 ? FB : MIX), CF, (const float*)NQK};
        const attn_body::StaticOrder S(G, bx);
        attn_body::attn_phase<attn_body::StaticOrder>((char*)lds_raw, AT, S);
        }
    }
    SEAM(6);
    if (IN(7)) for (int rep_ = 0; rep_ < ((PRB(2) || PRB(8)) ? 2 : 1); ++rep_) { gla_out_phase(lds, BCG, GQK, MIX, (PRB(2) || PRB(8)) && rep_ == 0 ? KV : MIX, GR, (const bf16*)FB, args.in[11], bx, G, tid); __syncthreads(); }
    SEAM(7);
    if (IN(8)) { pg8::Gemm g{MIX, W_OUT, T, DM, DM}; pg8::StaticOrder S; S.init(T, DM, G, bx); pg8::EpiRowSS E{FB, DM, ROWSS};
        pg8::gemm_phase<pg8::EpiRowSS, pg8::StaticOrder, GEMM_ALIGN, GEMM_SP2>(lds, g, S, E); }
    SEAM(8);
    if (IN(9)) { for (int m = gw; m < T; m += 2 * NGW) row_update<true, true, false, true, 2>(XB, FB, ROWSS, args.in[13], 1.0f, nullptr, XB, RSTD, m, NGW, lane); }
    SEAM(9);
    if (IN(10)) {
        { pg8::Gemm g{XB, W_MQ, T, DM, DM}; pg8::StaticOrder S; S.init(T, DM, G, bx); pg8::EpiScale E{QM, DM, RSTD, (1.f / 16.f) * LOG2E};
          pg8::gemm_phase<pg8::EpiScale, pg8::StaticOrder, GEMM_ALIGN, GEMM_SP2>(lds, g, S, E);
          xattn_phase(lds, QM, KM, VTm, OM, S, tid); __syncthreads(); }
    }
    SEAM(11);
    if (IN(12)) { pg8::Gemm g{OM, W_MO, T, DM, DM}; pg8::StaticOrder S; S.init(T, DM, G, bx); pg8::EpiRowSS E{FB, DM, ROWSS};
        pg8::gemm_phase<pg8::EpiRowSS, pg8::StaticOrder, GEMM_ALIGN, GEMM_SP2>(lds, g, S, E); }
    SEAM(12);
    if (IN(13)) { for (int m = gw; m < T; m += 2 * NGW) row_update<true, true, false, true, 2>(XB, FB, ROWSS, args.in[19], 1.0f, nullptr, XB, RSTD, m, NGW, lane); }
    SEAM(13);
    if (IN(14)) { pg8::Gemm g{XB, W_GU2, T, NGU, DM}; pg8::StaticOrder S; S.init(T, NGU, G, bx); pg8::EpiSwiGLU E{ACT, FF, RSTD};
        pg8::gemm_phase<pg8::EpiSwiGLU, pg8::StaticOrder, GU_ALIGN, GEMM_SP2>(lds, g, S, E); }
    SEAM(14);
    if (IN(15)) { pg8::Gemm g{ACT, W_D2, T, DM, FF}; pg8::StaticOrder S; S.init(T, DM, G, bx); pg8::EpiRowSS E{FB, DM, ROWSS};
        pg8::gemm_phase<pg8::EpiRowSS, pg8::StaticOrder, GEMM_ALIGN, GEMM_SP2>(lds, g, S, E); }
    SEAM(15);
    if (IN(16)) { for (int m = gw; m < T; m += 2 * NGW) row_update<true, true, true, false, 2>(XB, FB, ROWSS, args.in[23], 0.5f, args.out, nullptr, nullptr, m, NGW, lane); }
#undef IN
#undef SEAM
}

#ifndef MK_N_LAUNCHES
#define MK_N_LAUNCHES 1
#endif
extern "C" void kernel_launch(void* const* d_in, const int* in_sizes, int n_in, void* d_out, int out_size, void* d_ws, size_t ws_size, hipStream_t stream) {
    static int grid = 0;
    if (grid == 0) {
        if (n_in != 24 || in_sizes[0] != T * DM || out_size != T * DM || ws_size < WS_END) { fprintf(stderr, "kernel_launch: unexpected shapes (n_in %d, in0 %d, out %d, ws %zu); nothing launched\n", n_in, n_in > 0 ? in_sizes[0] : -1, out_size, ws_size); grid = -1; return; }
        int dev = 0, cus = 0, per_cu = 0;
        if (hipGetDevice(&dev) != hipSuccess || hipDeviceGetAttribute(&cus, hipDeviceAttributeMultiprocessorCount, dev) != hipSuccess) { grid = -1; return; }
        if (hipFuncSetAttribute((const void*)layer_fwd, hipFuncAttributeMaxDynamicSharedMemorySize, LDS_BYTES) != hipSuccess) { fprintf(stderr, "kernel_launch: hipFuncSetAttribute failed\n"); grid = -1; return; }
        if (hipOccupancyMaxActiveBlocksPerMultiprocessor(&per_cu, (const void*)layer_fwd, NTHR, LDS_BYTES) != hipSuccess || per_cu < 1) { fprintf(stderr, "kernel_launch: occupancy query says %d\n", per_cu); per_cu = 1; }
        (void)hipGetLastError();
        grid = cus * per_cu;
        if (grid < 256) { fprintf(stderr, "kernel_launch: this kernel is laid out for 256 co-resident workgroups (one per CU); the device offers %d\n", grid); grid = -1; return; }
        grid = 256;
    }
    if (grid < 0) return;
    if (hipMemsetAsync((char*)d_ws + WS_CTL, 0, CTL_ZERO_BYTES, stream) != hipSuccess) { fprintf(stderr, "kernel_launch: memset failed\n"); return; }
    Args a{};
    for (int i = 0; i < 24; ++i) a.in[i] = (const float*)d_in[i];
    a.out = (float*)d_out; a.ws = (unsigned char*)d_ws;
#if MK_N_LAUNCHES == 1
    a.ph_lo = 0; a.ph_hi = NPH;
    void* kargs[] = {&a};
    hipError_t e = hipLaunchCooperativeKernel((const void*)layer_fwd, dim3(grid), dim3(NTHR), kargs, LDS_BYTES, stream);
    if (e != hipSuccess) fprintf(stderr, "kernel_launch: cooperative launch failed: %s (grid %d)\n", hipGetErrorString(e), grid);
#else
    for (int p = 0; p < NPH; ++p) { a.ph_lo = p; a.ph_hi = p + 1; hipLaunchKernelGGL(layer_fwd, dim3(grid), dim3(NTHR), LDS_BYTES, stream, a); }
#endif
}
```
